# Optimizing an MI355X kernel written in HIP

```python
import math
import jax
import jax.numpy as jnp
from jax import lax
import numpy as np

D_MODEL = 2048
BATCH = 1
SEQ = 8192
DEPTH = 4

N_MIXERS = 4
NORM_EPS = 1e-6
NEG_INF = -1e30

LRU_WIDTH = D_MODEL
LRU_BLOCKS = 16
LRU_BLOCK_W = LRU_WIDTH // LRU_BLOCKS
CONV_W = 4
CONV_PAD = (2, 1)
RGLRU_C = 8.0

HEAD_DIM = 128
ROT_DIM = HEAD_DIM // 4
ROPE_THETA = 500000.0
Q_BLOCK = 128

DIFF_HEADS = 8
DIFF_V_DIM = 2 * HEAD_DIM
DIFF_QK_WIDTH = DIFF_HEADS * 2 * HEAD_DIM

WIN_Q_HEADS = 16
WIN_KV_HEADS = 4
WIN_GROUP = WIN_Q_HEADS // WIN_KV_HEADS
WINDOW = 128
WIN_BLOCK = WINDOW

SSM_WIDTH = D_MODEL // 2
SSM_GROUP_CH = 16
SSM_GROUPS = SSM_WIDTH // SSM_GROUP_CH
SSM_STATE = 64

MOE_GROUPS = 4
EXPERTS_PER_GROUP = 8
N_EXPERTS = MOE_GROUPS * EXPERTS_PER_GROUP
TOP_K = 2
D_EXPERT = D_MODEL // 4
EXPERT_BLOCK = 128

kernel_name = 'hybrid_interleaved_bidir_encoder'

F32 = jnp.float32


def rms_norm(x, g):
    xf = x.astype(F32)
    y = xf * lax.rsqrt(jnp.mean(xf * xf, axis=-1, keepdims=True) + NORM_EPS)
    return (y * g.astype(F32)).astype(x.dtype)


def rope_tables(positions):
    inv = ROPE_THETA ** (-jnp.arange(0, ROT_DIM, 2, dtype=F32) / ROT_DIM)
    ang = positions.astype(F32)[..., None] * inv
    return jnp.cos(ang), jnp.sin(ang)


def partial_rope(x, cos, sin):
    half = ROT_DIM // 2
    shp = cos.shape[:2] + (1,) * (x.ndim - 3) + (half,)
    c = cos.reshape(shp).astype(x.dtype)
    s = sin.reshape(shp).astype(x.dtype)
    x1 = x[..., :half]
    x2 = x[..., half:ROT_DIM]
    return jnp.concatenate([x1 * c - x2 * s, x2 * c + x1 * s, x[..., ROT_DIM:]], axis=-1)


def _flip(t):
    return jnp.flip(t, axis=1)


def _lin_comb(l, r):
    return (l[0] * r[0], r[0] * l[1] + r[1])


def _cplx_comb(l, r):
    lar, lai, lbr, lbi = l
    rar, rai, rbr, rbi = r
    return (lar * rar - lai * rai,
            lar * rai + lai * rar,
            rar * lbr - rai * lbi + rbr,
            rar * lbi + rai * lbr + rbi)


def rglru_direction(xr, w_a, w_x, b_a, b_x, lam):
    b_, s_, w_ = xr.shape
    xh = xr.reshape(b_, s_, LRU_BLOCKS, LRU_BLOCK_W)
    r = jax.nn.sigmoid(jnp.einsum('bshi,hij->bshj', xh, w_a.astype(F32)).reshape(b_, s_, w_) + b_a.astype(F32))
    i = jax.nn.sigmoid(jnp.einsum('bshi,hij->bshj', xh, w_x.astype(F32)).reshape(b_, s_, w_) + b_x.astype(F32))
    log_a = -RGLRU_C * r * jax.nn.softplus(-lam.astype(F32))
    a = jnp.exp(log_a)
    b = jnp.sqrt(-jnp.expm1(2.0 * log_a)) * (i * xr)
    return lax.associative_scan(_lin_comb, (a, b), axis=1)[1]


def rglru_mixer(h, w_in, conv_w, conv_b, w_a, w_x, b_a, b_x, lam, w_out):
    proj = h @ w_in
    gate, xr = jnp.split(proj, 2, axis=-1)
    xr = lax.conv_general_dilated(xr, conv_w[:, None, :], window_strides=(1,), padding=[CONV_PAD],
                                  dimension_numbers=('NWC', 'WIO', 'NWC'),
                                  feature_group_count=LRU_WIDTH) + conv_b
    xr = xr.astype(F32)
    y = (rglru_direction(xr, w_a[0], w_x[0], b_a[0], b_x[0], lam[0])
         + _flip(rglru_direction(_flip(xr), w_a[1], w_x[1], b_a[1], b_x[1], lam[1])))
    return (y.astype(h.dtype) * jax.nn.gelu(gate)) @ w_out


def diff_attn_mixer(h, cos, sin, w_qkv, lq1, lk1, lq2, lk2, subln_g, w_out, lambda_init):
    b_, s_, _ = h.shape
    q, k, v = jnp.split(h @ w_qkv, [DIFF_QK_WIDTH, 2 * DIFF_QK_WIDTH], axis=-1)
    q = partial_rope(q.reshape(b_, s_, DIFF_HEADS, 2, HEAD_DIM), cos, sin)
    k = partial_rope(k.reshape(b_, s_, DIFF_HEADS, 2, HEAD_DIM), cos, sin)
    v = v.reshape(b_, s_, DIFF_HEADS, DIFF_V_DIM)
    lam = (jnp.exp(jnp.sum(lq1.astype(F32) * lk1.astype(F32)))
           - jnp.exp(jnp.sum(lq2.astype(F32) * lk2.astype(F32))) + lambda_init)
    scale = HEAD_DIM ** -0.5
    n_qb = s_ // Q_BLOCK
    qb = jnp.moveaxis(q.reshape(b_, n_qb, Q_BLOCK, DIFF_HEADS, 2, HEAD_DIM), 1, 0)

    def block(qblk):
        s = jnp.einsum('bqhcd,bkhcd->bhcqk', qblk, k).astype(F32) * scale
        p = jax.nn.softmax(s, axis=-1)
        wdiff = p[:, :, 0] - lam * p[:, :, 1]
        return jnp.einsum('bhqk,bkhe->bqhe', wdiff.astype(v.dtype), v)

    o = jnp.moveaxis(lax.map(block, qb), 0, 1).reshape(b_, s_, DIFF_HEADS, DIFF_V_DIM)
    o = rms_norm(o, subln_g) * (1.0 - lambda_init)
    return o.reshape(b_, s_, DIFF_HEADS * DIFF_V_DIM) @ w_out


def window_gqa_mixer(h, cos, sin, w_qkv, sink, w_out):
    b_, s_, _ = h.shape
    qd = WIN_Q_HEADS * HEAD_DIM
    kd = WIN_KV_HEADS * HEAD_DIM
    q, k, v = jnp.split(h @ w_qkv, [qd, qd + kd], axis=-1)
    q = partial_rope(q.reshape(b_, s_, WIN_KV_HEADS, WIN_GROUP, HEAD_DIM), cos, sin)
    k = partial_rope(k.reshape(b_, s_, WIN_KV_HEADS, HEAD_DIM), cos, sin)
    v = v.reshape(b_, s_, WIN_KV_HEADS, HEAD_DIM)
    nb = s_ // WIN_BLOCK
    qb = q.reshape(b_, nb, WIN_BLOCK, WIN_KV_HEADS, WIN_GROUP, HEAD_DIM)

    def band(t):
        tp = jnp.pad(t, ((0, 0), (WIN_BLOCK, WIN_BLOCK), (0, 0), (0, 0)))
        tp = tp.reshape(b_, nb + 2, WIN_BLOCK, WIN_KV_HEADS, HEAD_DIM)
        return jnp.concatenate([tp[:, :-2], tp[:, 1:-1], tp[:, 2:]], axis=2)

    kb, vb = band(k), band(v)
    s = jnp.einsum('bnqkgd,bnmkd->bnkgqm', qb, kb).astype(F32) * (HEAD_DIM ** -0.5)
    qi = jnp.arange(WIN_BLOCK)[:, None]
    mi = jnp.arange(3 * WIN_BLOCK)[None, :]
    rel = mi - WIN_BLOCK - qi
    key_pos = jnp.arange(nb)[:, None, None] * WIN_BLOCK - WIN_BLOCK + mi[None]
    valid = (jnp.abs(rel) <= WINDOW)[None] & (key_pos >= 0) & (key_pos < s_)
    s = jnp.where(valid[None, :, None, None], s, NEG_INF)
    sink_l = sink.astype(F32).reshape(1, 1, WIN_KV_HEADS, WIN_GROUP, 1, 1)
    m = jnp.maximum(jnp.max(s, axis=-1, keepdims=True), sink_l)
    e = jnp.exp(s - m)
    p = e / (jnp.sum(e, axis=-1, keepdims=True) + jnp.exp(sink_l - m))
    o = jnp.einsum('bnkgqm,bnmkd->bnqkgd', p.astype(vb.dtype), vb)
    return o.reshape(b_, s_, qd) @ w_out


def s5_direction(u, a_re, a_im, log_dt, b_re, b_im, c_re, c_im):
    a_re, a_im = a_re.astype(F32), a_im.astype(F32)
    b_re, b_im = b_re.astype(F32), b_im.astype(F32)
    dt = jnp.exp(log_dt.astype(F32))[:, None]
    mag = jnp.exp(dt * a_re)
    lr, li = mag * jnp.cos(dt * a_im), mag * jnp.sin(dt * a_im)
    den = a_re * a_re + a_im * a_im
    nr, ni = lr - 1.0, li
    fr = (nr * a_re + ni * a_im) / den
    fi = (ni * a_re - nr * a_im) / den
    bbr = fr[..., None] * b_re - fi[..., None] * b_im
    bbi = fr[..., None] * b_im + fi[..., None] * b_re
    xr = jnp.einsum('gnc,bsgc->bsgn', bbr, u)
    xi = jnp.einsum('gnc,bsgc->bsgn', bbi, u)
    ar = jnp.broadcast_to(lr, xr.shape)
    ai = jnp.broadcast_to(li, xr.shape)
    _, _, sr, si = lax.associative_scan(_cplx_comb, (ar, ai, xr, xi), axis=1)
    return (jnp.einsum('gcn,bsgn->bsgc', c_re.astype(F32), sr)
            - jnp.einsum('gcn,bsgn->bsgc', c_im.astype(F32), si))


def s5_mixer(h, w_in, a_re, a_im, log_dt, b_re, b_im, c_re, c_im, d_skip, w_glu, w_out):
    b_, s_, _ = h.shape
    u = (h @ w_in).astype(F32)
    ug = u.reshape(b_, s_, SSM_GROUPS, SSM_GROUP_CH)
    y = (s5_direction(ug, a_re[0], a_im[0], log_dt[0], b_re[0], b_im[0], c_re[0], c_im[0])
         + _flip(s5_direction(_flip(ug), a_re[1], a_im[1], log_dt[1], b_re[1], b_im[1], c_re[1], c_im[1])))
    y = y.reshape(b_, s_, SSM_WIDTH) + d_skip.astype(F32) * u
    g = jax.nn.gelu(y).astype(h.dtype)
    z = g * jax.nn.sigmoid(g @ w_glu)
    return z @ w_out


def hier_moe(x2d, w_group, w_expert, w_gate, w_up, w_down):
    n_tok, d = x2d.shape
    g_prob = jax.nn.softmax((x2d @ w_group).astype(F32), axis=-1)
    g_p, g_idx = lax.top_k(g_prob, 1)
    e_logits = (x2d @ w_expert).astype(F32).reshape(n_tok, MOE_GROUPS, EXPERTS_PER_GROUP)
    e_sel = e_logits[jnp.arange(n_tok), g_idx[:, 0]]
    e_p, e_idx = lax.top_k(jax.nn.softmax(e_sel, axis=-1), TOP_K)
    e_p = e_p / jnp.sum(e_p, axis=-1, keepdims=True)
    weights = (g_p * e_p).reshape(-1)
    expert = (g_idx * EXPERTS_PER_GROUP + e_idx).reshape(-1).astype(jnp.int32)
    n_asg = n_tok * TOP_K
    tok = jnp.arange(n_asg, dtype=jnp.int32) // TOP_K
    order = jnp.argsort(expert, stable=True)
    se, stok, sw = expert[order], tok[order], weights[order]
    counts = jax.ops.segment_sum(jnp.ones_like(expert), expert, num_segments=N_EXPERTS)
    starts = jnp.cumsum(counts) - counts
    padded = ((counts + EXPERT_BLOCK - 1) // EXPERT_BLOCK) * EXPERT_BLOCK
    pends = jnp.cumsum(padded)
    pstarts = pends - padded
    dest = pstarts[se] + jnp.arange(n_asg, dtype=jnp.int32) - starts[se]
    n_rows = -(-(n_asg + N_EXPERTS * (EXPERT_BLOCK - 1)) // EXPERT_BLOCK) * EXPERT_BLOCK
    n_blk = n_rows // EXPERT_BLOCK
    row_tok = jnp.full((n_rows,), n_tok, jnp.int32).at[dest].set(stok)
    row_w = jnp.zeros((n_rows,), F32).at[dest].set(sw)
    blk_start = jnp.arange(n_blk, dtype=jnp.int32) * EXPERT_BLOCK
    blk_e = jnp.minimum(jnp.searchsorted(pends, blk_start, side='right'), N_EXPERTS - 1)
    x_pad = jnp.concatenate([x2d, jnp.zeros((1, d), x2d.dtype)], axis=0)
    xs = x_pad[row_tok].reshape(n_blk, EXPERT_BLOCK, d)

    def expert_block(args):
        xb, e = args
        hdn = jax.nn.silu(xb @ w_gate[e]) * (xb @ w_up[e])
        return hdn @ w_down[e]

    ys = lax.map(expert_block, (xs, blk_e)).reshape(n_rows, d)
    out = jnp.zeros((n_tok + 1, d), F32).at[row_tok].add(ys.astype(F32) * row_w[:, None])
    return out[:n_tok].astype(x2d.dtype)


def _normal(k, shape, scale):
    return jax.random.normal(k, shape, F32) * scale


def setup_inputs(seed: int = 0) -> dict:
    key = jax.random.key(seed)
    ks = list(jax.random.split(key, 48))
    n_a = (DEPTH + 3) // 4
    n_b = (DEPTH + 2) // 4
    n_c = (DEPTH + 1) // 4
    n_d = DEPTH // 4
    d = D_MODEL
    x = jax.random.normal(ks[0], (BATCH, SEQ, d), F32)
    positions = jnp.broadcast_to(jnp.arange(SEQ, dtype=jnp.int32), (BATCH, SEQ))
    ln_mix = 1.0 + _normal(ks[1], (DEPTH, d), 0.01)
    ln_ffn = 1.0 + _normal(ks[2], (DEPTH, d), 0.01)
    ln_final = 1.0 + _normal(ks[3], (d,), 0.01)
    lru_w_in = _normal(ks[4], (n_a, d, 2 * LRU_WIDTH), d ** -0.5)
    lru_conv_w = _normal(ks[5], (n_a, CONV_W, LRU_WIDTH), CONV_W ** -0.5)
    lru_conv_b = _normal(ks[6], (n_a, LRU_WIDTH), 0.01)
    lru_w_a = _normal(ks[7], (n_a, 2, LRU_BLOCKS, LRU_BLOCK_W, LRU_BLOCK_W), LRU_BLOCK_W ** -0.5)
    lru_w_x = _normal(ks[8], (n_a, 2, LRU_BLOCKS, LRU_BLOCK_W, LRU_BLOCK_W), LRU_BLOCK_W ** -0.5)
    lru_b_a = _normal(ks[9], (n_a, 2, LRU_WIDTH), 0.1)
    lru_b_x = _normal(ks[10], (n_a, 2, LRU_WIDTH), 0.1)
    a_pow = jax.random.uniform(ks[11], (n_a, 2, LRU_WIDTH), F32, 0.9, 0.999) ** (1.0 / RGLRU_C)
    lru_lambda = jnp.log(a_pow) - jnp.log1p(-a_pow)
    lru_w_out = _normal(ks[12], (n_a, LRU_WIDTH, d), LRU_WIDTH ** -0.5)
    diff_w_qkv = _normal(ks[13], (n_b, d, 3 * DIFF_QK_WIDTH), d ** -0.5)
    diff_lq1 = _normal(ks[14], (n_b, HEAD_DIM), 0.1)
    diff_lk1 = _normal(ks[15], (n_b, HEAD_DIM), 0.1)
    diff_lq2 = _normal(ks[16], (n_b, HEAD_DIM), 0.1)
    diff_lk2 = _normal(ks[17], (n_b, HEAD_DIM), 0.1)
    diff_subln = 1.0 + _normal(ks[18], (n_b, DIFF_V_DIM), 0.01)
    diff_w_out = _normal(ks[19], (n_b, DIFF_HEADS * DIFF_V_DIM, d), (DIFF_HEADS * DIFF_V_DIM) ** -0.5)
    win_w_qkv = _normal(ks[20], (n_c, d, (WIN_Q_HEADS + 2 * WIN_KV_HEADS) * HEAD_DIM), d ** -0.5)
    win_sink = _normal(ks[21], (n_c, WIN_Q_HEADS), 0.5)
    win_w_out = _normal(ks[22], (n_c, WIN_Q_HEADS * HEAD_DIM, d), (WIN_Q_HEADS * HEAD_DIM) ** -0.5)
    s5_w_in = _normal(ks[23], (n_d, d, SSM_WIDTH), d ** -0.5)
    st_shape = (n_d, 2, SSM_GROUPS, SSM_STATE)
    s5_a_re = -0.5 + _normal(ks[24], st_shape, 0.01)
    s5_a_im = jnp.pi * jnp.arange(SSM_STATE, dtype=F32) + _normal(ks[25], st_shape, 0.01)
    s5_log_dt = jax.random.uniform(ks[26], (n_d, 2, SSM_GROUPS), F32, math.log(1e-3), math.log(1e-1))
    s5_b_re = _normal(ks[27], (n_d, 2, SSM_GROUPS, SSM_STATE, SSM_GROUP_CH), (2 * SSM_GROUP_CH) ** -0.5)
    s5_b_im = _normal(ks[28], (n_d, 2, SSM_GROUPS, SSM_STATE, SSM_GROUP_CH), (2 * SSM_GROUP_CH) ** -0.5)
    s5_c_re = _normal(ks[29], (n_d, 2, SSM_GROUPS, SSM_GROUP_CH, SSM_STATE), 0.5)
    s5_c_im = _normal(ks[30], (n_d, 2, SSM_GROUPS, SSM_GROUP_CH, SSM_STATE), 0.5)
    s5_d = 1.0 + _normal(ks[31], (n_d, SSM_WIDTH), 0.1)
    s5_w_glu = _normal(ks[32], (n_d, SSM_WIDTH, SSM_WIDTH), SSM_WIDTH ** -0.5)
    s5_w_out = _normal(ks[33], (n_d, SSM_WIDTH, d), SSM_WIDTH ** -0.5)
    moe_w_group = _normal(ks[34], (DEPTH, d, MOE_GROUPS), d ** -0.5)
    moe_w_expert = _normal(ks[35], (DEPTH, d, N_EXPERTS), d ** -0.5)
    moe_w_gate = _normal(ks[36], (DEPTH, N_EXPERTS, d, D_EXPERT), d ** -0.5)
    moe_w_up = _normal(ks[37], (DEPTH, N_EXPERTS, d, D_EXPERT), d ** -0.5)
    moe_w_down = _normal(ks[38], (DEPTH, N_EXPERTS, D_EXPERT, d), D_EXPERT ** -0.5)
    return {'x': x, 'positions': positions, 'ln_mix': ln_mix, 'ln_ffn': ln_ffn, 'ln_final': ln_final,
            'lru_w_in': lru_w_in, 'lru_conv_w': lru_conv_w, 'lru_conv_b': lru_conv_b,
            'lru_w_a': lru_w_a, 'lru_w_x': lru_w_x, 'lru_b_a': lru_b_a, 'lru_b_x': lru_b_x,
            'lru_lambda': lru_lambda, 'lru_w_out': lru_w_out,
            'diff_w_qkv': diff_w_qkv, 'diff_lq1': diff_lq1, 'diff_lk1': diff_lk1,
            'diff_lq2': diff_lq2, 'diff_lk2': diff_lk2, 'diff_subln': diff_subln, 'diff_w_out': diff_w_out,
            'win_w_qkv': win_w_qkv, 'win_sink': win_sink, 'win_w_out': win_w_out,
            's5_w_in': s5_w_in, 's5_a_re': s5_a_re, 's5_a_im': s5_a_im, 's5_log_dt': s5_log_dt,
            's5_b_re': s5_b_re, 's5_b_im': s5_b_im, 's5_c_re': s5_c_re, 's5_c_im': s5_c_im,
            's5_d': s5_d, 's5_w_glu': s5_w_glu, 's5_w_out': s5_w_out,
            'moe_w_group': moe_w_group, 'moe_w_expert': moe_w_expert, 'moe_w_gate': moe_w_gate,
            'moe_w_up': moe_w_up, 'moe_w_down': moe_w_down}


def reference(x, positions, ln_mix, ln_ffn, ln_final,
              lru_w_in, lru_conv_w, lru_conv_b, lru_w_a, lru_w_x, lru_b_a, lru_b_x, lru_lambda, lru_w_out,
              diff_w_qkv, diff_lq1, diff_lk1, diff_lq2, diff_lk2, diff_subln, diff_w_out,
              win_w_qkv, win_sink, win_w_out,
              s5_w_in, s5_a_re, s5_a_im, s5_log_dt, s5_b_re, s5_b_im, s5_c_re, s5_c_im, s5_d, s5_w_glu, s5_w_out,
              moe_w_group, moe_w_expert, moe_w_gate, moe_w_up, moe_w_down):
    cos, sin = rope_tables(positions)
    for i in range(DEPTH):
        kind, j = i % N_MIXERS, i // N_MIXERS
        h = rms_norm(x, ln_mix[i])
        if kind == 0:
            y = rglru_mixer(h, lru_w_in[j], lru_conv_w[j], lru_conv_b[j], lru_w_a[j], lru_w_x[j],
                            lru_b_a[j], lru_b_x[j], lru_lambda[j], lru_w_out[j])
        elif kind == 1:
            y = diff_attn_mixer(h, cos, sin, diff_w_qkv[j], diff_lq1[j], diff_lk1[j], diff_lq2[j],
                                diff_lk2[j], diff_subln[j], diff_w_out[j],
                                0.8 - 0.6 * math.exp(-0.3 * i))
        elif kind == 2:
            y = window_gqa_mixer(h, cos, sin, win_w_qkv[j], win_sink[j], win_w_out[j])
        else:
            y = s5_mixer(h, s5_w_in[j], s5_a_re[j], s5_a_im[j], s5_log_dt[j], s5_b_re[j], s5_b_im[j],
                         s5_c_re[j], s5_c_im[j], s5_d[j], s5_w_glu[j], s5_w_out[j])
        x = x + y.astype(x.dtype)
        h = rms_norm(x, ln_ffn[i])
        moe_out = hier_moe(h.reshape(-1, D_MODEL), moe_w_group[i], moe_w_expert[i],
                           moe_w_gate[i], moe_w_up[i], moe_w_down[i])
        x = x + moe_out.reshape(x.shape).astype(x.dtype)
    return rms_norm(x, ln_final)
```

```cpp
#include <hip/hip_runtime.h>
#include <cstdio>
#include <cstdint>

#define LAS __attribute__((address_space(3)))
typedef unsigned short bf16_t;
typedef short bf16x8 __attribute__((ext_vector_type(8)));
typedef short s16x4 __attribute__((ext_vector_type(4)));
typedef float f32x2 __attribute__((ext_vector_type(2)));
typedef float f32x4 __attribute__((ext_vector_type(4)));
typedef float f32x8 __attribute__((ext_vector_type(8)));
typedef float f32x16 __attribute__((ext_vector_type(16)));
typedef unsigned u32x2 __attribute__((ext_vector_type(2)));
typedef unsigned u32x4 __attribute__((ext_vector_type(4)));

#ifndef BAR_REP
#define BAR_REP 1
#endif
#ifndef ROUTER_REP
#define ROUTER_REP 1
#endif
constexpr int S_ = 8192, D_ = 2048, NTHREADS = 512;
constexpr int N_EXP = 32, D_EXP = 512;
constexpr float NORM_EPS = 1e-6f;
#ifndef MK_SPLIT
#define MK_SPLIT 0
#endif
constexpr int MAXTILES = 96;
constexpr int NCH = 128, CHL = 64;

__device__ __forceinline__ unsigned cvt_pk_bf16(float lo, float hi) { unsigned r; asm volatile("v_cvt_pk_bf16_f32 %0, %1, %2" : "=v"(r) : "v"(lo), "v"(hi)); return r; }
__device__ __forceinline__ bf16_t f2bf(float x) { return (bf16_t)(cvt_pk_bf16(x, x) & 0xffffu); }
__device__ __forceinline__ float bf2f(bf16_t b) { return __uint_as_float(((unsigned)b) << 16); }
__device__ __forceinline__ float bflo(unsigned w) { return __uint_as_float(w << 16); }
__device__ __forceinline__ float bfhi(unsigned w) { return __uint_as_float(w & 0xffff0000u); }
__device__ __forceinline__ float sigmoidf_(float x) { return __builtin_amdgcn_rcpf(1.0f + __expf(-x)); }
__device__ __forceinline__ float gelu_tanh(float v) { const float u = 1.5957691216057308f * (v + 0.044715f * v * v * v); return v * __builtin_amdgcn_rcpf(1.0f + __expf(-u)); }
__device__ __forceinline__ f32x2 exp2_2(const f32x2 x) { return (f32x2){__builtin_amdgcn_exp2f(x[0]), __builtin_amdgcn_exp2f(x[1])}; }
__device__ __forceinline__ f32x2 rcp_2(const f32x2 x) { return (f32x2){__builtin_amdgcn_rcpf(x[0]), __builtin_amdgcn_rcpf(x[1])}; }
__device__ __forceinline__ f32x2 sigmoid_2(const f32x2 x) { return rcp_2(exp2_2(x * (-1.4426950408889634f)) + 1.0f); }
__device__ __forceinline__ f32x2 gelu_tanh_2(const f32x2 v) {
    const f32x2 w = (v * v) * (-1.4426950408889634f * 1.5957691216057308f * 0.044715f) + (-1.4426950408889634f * 1.5957691216057308f);
    return v * rcp_2(exp2_2(v * w) + 1.0f); }
#define LO2(x) ((f32x2){(x)[0], (x)[1]})
#define HI2(x) ((f32x2){(x)[2], (x)[3]})
__device__ __forceinline__ float wave_sum(float v) {
#pragma unroll
    for (int o = 32; o >= 1; o >>= 1) v += __shfl_xor(v, o);
    return v;
}

#define XB_TMO      128
#define XB_XCNT(j)  (256  + 64 * (j))
#define XB_XSUB(j)  (1280 + 64 * (j))
#define XB_XGEN(j)  (2304 + 64 * (j))
#define XB_TOP      3328
#define XB_TOPGEN   3392
#define XCD_BAR_WORDS 3456
#define XB_SPIN_CAP (1u << 18)
__device__ __forceinline__ unsigned xb_ld(unsigned* p)              { return __hip_atomic_load(p, __ATOMIC_RELAXED, __HIP_MEMORY_SCOPE_AGENT); }
__device__ __forceinline__ unsigned xb_add(unsigned* p, unsigned v) { return __hip_atomic_fetch_add(p, v, __ATOMIC_RELAXED, __HIP_MEMORY_SCOPE_AGENT); }
__device__ __forceinline__ unsigned xb_xcc_id() { return (unsigned)__builtin_amdgcn_s_getreg((3 << 11) | 20) & 0xFu; }
#define XB_SPIN(cond, bar) do { unsigned _sp = 0; while (cond) { __builtin_amdgcn_s_sleep(1); \
    if ((++_sp & 255u) == 0u) { if (xb_ld(&(bar)[XB_TMO])) break; if (_sp > XB_SPIN_CAP) { atomicAdd(&(bar)[XB_TMO], 1u); break; } } } } while (0)
struct XcdBarrier { unsigned* bar; unsigned x; volatile LAS unsigned* st; unsigned G; };
__device__ __forceinline__ XcdBarrier xcd_barrier_post(unsigned* bar, volatile LAS unsigned* st, int tid, unsigned G) {
    XcdBarrier b; b.bar = bar; b.x = xb_xcc_id(); b.st = st; b.G = G;
    if (tid == 0) (void)xb_add(&bar[XB_XCNT(b.x)], 1u);
    return b;
}
__device__ __forceinline__ void xcd_barrier_complete(unsigned* bar, unsigned x, unsigned& nloc, unsigned& nx, const unsigned G) {
    unsigned sum, cnt, mine, sp = 0u;
    for (;;) {
        sum = 0u; cnt = 0u; mine = 0u;
#pragma unroll
        for (unsigned j = 0; j < 16; ++j) { const unsigned c = xb_ld(&bar[XB_XCNT(j)]); sum += c; cnt += (c > 0u) ? 1u : 0u; mine = (j == x) ? c : mine; }
        if (sum == G) break;
        __builtin_amdgcn_s_sleep(1);
        if ((++sp & 255u) == 0u) { if (xb_ld(&bar[XB_TMO])) break; if (sp > XB_SPIN_CAP) { atomicAdd(&bar[XB_TMO], 1u); break; } }
    }
    nloc = mine > 0u ? mine : 1u; nx = cnt > 0u ? cnt : 1u;
}
__device__ __forceinline__ void xcd_barrier(const XcdBarrier& b, int tid) {
    asm volatile("s_waitcnt vmcnt(0)" ::: "memory");
    __syncthreads();
    if (tid == 0) {
        unsigned* bar = b.bar;
        __builtin_amdgcn_s_waitcnt(0);
        unsigned nloc = b.st[0], nx = b.st[1];
        if (nloc == 0u) { xcd_barrier_complete(bar, b.x, nloc, nx, b.G); b.st[0] = nloc; b.st[1] = nx; }
        const unsigned old = xb_add(&bar[XB_XSUB(b.x)], 1u);
        const unsigned gen = old / nloc;
        if (old + 1u == (gen + 1u) * nloc) {
            __builtin_amdgcn_fence(__ATOMIC_RELEASE, "agent");
            asm volatile("s_waitcnt vmcnt(0)" ::: "memory");
            const unsigned og = xb_add(&bar[XB_TOP], 1u);
            const unsigned tg = og / nx;
            if (og + 1u == (tg + 1u) * nx) xb_add(&bar[XB_TOPGEN], 1u);
            else XB_SPIN(xb_ld(&bar[XB_TOPGEN]) == tg, bar);
            __builtin_amdgcn_fence(__ATOMIC_ACQUIRE, "agent");
            xb_add(&bar[XB_XGEN(b.x)], 1u);
            asm volatile("s_waitcnt vmcnt(0)" ::: "memory");
        } else {
            XB_SPIN(xb_ld(&bar[XB_XGEN(b.x)]) == gen, bar);
            __builtin_amdgcn_fence(__ATOMIC_ACQUIRE, "agent");
            asm volatile("s_waitcnt vmcnt(0)" ::: "memory");
        }
    }
    __syncthreads();
}

namespace pg {
constexpr int BM = 256, BK = 64, HALF = 128, HTB = HALF * BK * 2, STAGE_BYTES = 8 * HTB;
__device__ __forceinline__ int lds_byte(int r, int c) { const int st = (r >> 4) * 2 + (c >> 5), rr = r & 15, cc = c & 31, ob = rr * 64 + cc * 2; return st * 1024 + (ob ^ (((ob >> 9) & 1) << 5)); }
__device__ __forceinline__ void stage_rc(int b, int& R, int& C) { const int st = b / 1024, sb = b % 1024, swz = sb ^ (((sb >> 9) & 1) << 5); R = (st >> 1) * 16 + swz / 64; C = (st & 1) * 32 + (swz % 64) / 2; }
__device__ __forceinline__ int perm32(int rho) { const int n = rho >> 4, i = rho & 15; return 8 * (i >> 2) + 4 * n + (i & 3); }

struct Unit { int pm, pn, g, aux; };

template <class Epi, class Sched>
__device__ __forceinline__ void gemm_phase(LAS unsigned char* lds, const Sched& S, const Epi& E, const int K, const int lda, const int ldb, const int tid) {
    const int wid = __builtin_amdgcn_readfirstlane(tid >> 6), lane = tid & 63, wr = wid >> 2, wc = wid & 3, fr = lane & 15, fq = lane >> 4;
    const int nt = K / BK;
    int RA[2], CA[2]; unsigned vB[2][2];
#pragma unroll
    for (int i = 0; i < 2; ++i) { int R, C; stage_rc(tid * 16 + i * 8192, R, C); RA[i] = R; CA[i] = C; const int Rb = Epi::PERM ? ((R & ~31) + perm32(R & 31)) : R;
        vB[0][i] = (unsigned)(Rb * ldb + C) * 2u; vB[1][i] = (unsigned)((Rb + HALF) * ldb + C) * 2u; }
    const size_t kstep = (size_t)(BK * 2);
    const unsigned ldsw = (unsigned)wid * 1024u;
    const int aoff = lds_byte(wr * 64 + fr, fq * 8), boff = lds_byte(wc * 32 + fr, fq * 8);
#define PG_SA(b, h) (((b) * 2 + (h)) * HTB)
#define PG_SB(b, h) ((4 + (b) * 2 + (h)) * HTB)
#define PG_STAGE(bufoff, gbase, voff) do { _Pragma("unroll") for (int _i = 0; _i < 2; ++_i) \
        __builtin_amdgcn_global_load_lds((const unsigned*)((const char*)(gbase) + (voff)[_i]), (LAS unsigned*)(lds + (bufoff) + ldsw + _i * 8192), 16, 0, 0); } while (0)
#define PG_LDA(dst, b, h) do { _Pragma("unroll") for (int m = 0; m < 4; ++m) _Pragma("unroll") for (int k = 0; k < 2; ++k) dst[m][k] = *(const LAS bf16x8*)(lds + PG_SA(b, h) + aoff + m * 2048 + k * 1024); } while (0)
#define PG_LDB(dst, b, h) do { _Pragma("unroll") for (int n = 0; n < 2; ++n) _Pragma("unroll") for (int k = 0; k < 2; ++k) dst[n][k] = *(const LAS bf16x8*)(lds + PG_SB(b, h) + boff + n * 2048 + k * 1024); } while (0)
#define PG_MMA(ai, bj, At, Bt) do { __builtin_amdgcn_s_setprio(1); _Pragma("unroll") for (int m = 0; m < 4; ++m) _Pragma("unroll") for (int n = 0; n < 2; ++n) _Pragma("unroll") for (int k = 0; k < 2; ++k) \
        acc[ai][bj][m][n] = __builtin_amdgcn_mfma_f32_16x16x32_bf16(Bt[n][k], At[m][k], acc[ai][bj][m][n], 0, 0, 0); __builtin_amdgcn_s_setprio(0); } while (0)
#define PG_WAIT_V(n) asm volatile("s_waitcnt vmcnt(" #n ")" ::: "memory")
#define PG_WAIT_L(n) asm volatile("s_waitcnt lgkmcnt(" #n ")" ::: "memory")
#define PG_BAR __builtin_amdgcn_s_barrier()
#define PG_SCHED __builtin_amdgcn_sched_barrier(0)
#define PG_CALC_VA(dst, u) do { _Pragma("unroll") for (int _h = 0; _h < 2; ++_h) _Pragma("unroll") for (int _i = 0; _i < 2; ++_i) { const int _row = _h * HALF + RA[_i]; \
        const int _src = Sched::GATHER ? S.a_row(u, _row) : _row; dst[_h][_i] = (unsigned)(_src * lda + CA[_i]) * 2u; } } while (0)
    Unit cur, nxt; int ui = 0;
    if (!S.next(0, cur)) return;
    f32x4 acc[2][2][4][2];
#pragma unroll
    for (int a = 0; a < 2; ++a)
#pragma unroll
        for (int b = 0; b < 2; ++b)
#pragma unroll
            for (int m = 0; m < 4; ++m)
#pragma unroll
                for (int n = 0; n < 2; ++n) acc[a][b][m][n] = (f32x4){0.f, 0.f, 0.f, 0.f};
    bf16x8 At[4][2], B0[2][2], B1[2][2];
    unsigned vA[2][2], nvA[2][2];
    PG_CALC_VA(vA, cur);
    const char* cA = S.a_base(cur); const char* cB = S.b_base(cur);
    PG_STAGE(PG_SB(0, 0), cB, vB[0]); PG_STAGE(PG_SA(0, 0), cA, vA[0]); PG_STAGE(PG_SB(0, 1), cB, vB[1]); PG_STAGE(PG_SA(0, 1), cA, vA[1]);
    if (wr == 1) PG_BAR;
    PG_WAIT_V(4); PG_BAR;
    PG_STAGE(PG_SB(1, 0), cB + kstep, vB[0]); PG_STAGE(PG_SA(1, 0), cA + kstep, vA[0]); PG_STAGE(PG_SB(1, 1), cB + kstep, vB[1]);
    PG_WAIT_V(6); PG_BAR;
    for (;;) {
        const bool has_next = S.next(ui + 1, nxt);
        const char* nA = has_next ? S.a_base(nxt) : cA; const char* nB = has_next ? S.b_base(nxt) : cB;
        if (Sched::GATHER) { if (has_next) { PG_CALC_VA(nvA, nxt); } else {
#pragma unroll
            for (int h = 0; h < 2; ++h)
#pragma unroll
                for (int i = 0; i < 2; ++i) nvA[h][i] = vA[h][i]; } }
        else {
#pragma unroll
            for (int h = 0; h < 2; ++h)
#pragma unroll
                for (int i = 0; i < 2; ++i) nvA[h][i] = vA[h][i]; }
#pragma nounroll
        for (int t = 0; t < nt; t += 2) {
            const bool last = (t == nt - 2);
            const char* a1 = cA + (size_t)(t + 1) * kstep;
            const char* a2 = last ? nA : cA + (size_t)(t + 2) * kstep; const char* b2 = last ? nB : cB + (size_t)(t + 2) * kstep;
            const char* a3 = a2 + kstep; const char* b3 = b2 + kstep;
            unsigned sA[2][2];
#pragma unroll
            for (int h = 0; h < 2; ++h)
#pragma unroll
                for (int i = 0; i < 2; ++i) sA[h][i] = (Sched::GATHER && last) ? nvA[h][i] : vA[h][i];
            PG_LDB(B0, 0, 0); PG_SCHED; PG_LDA(At, 0, 0); PG_STAGE(PG_SA(1, 1), a1, vA[1]);
            PG_WAIT_L(8); PG_BAR; PG_WAIT_L(0); PG_MMA(0, 0, At, B0); PG_BAR; PG_SCHED;
            PG_LDB(B1, 0, 1); PG_STAGE(PG_SB(0, 0), b2, vB[0]);
            PG_BAR; PG_WAIT_L(0); PG_MMA(0, 1, At, B1); PG_BAR;
            PG_LDA(At, 0, 1); PG_STAGE(PG_SA(0, 0), a2, sA[0]);
            PG_BAR; PG_WAIT_L(0); PG_MMA(1, 0, At, B0); PG_BAR; PG_SCHED;
            PG_STAGE(PG_SB(0, 1), b2, vB[1]);
            PG_WAIT_V(6); PG_BAR; PG_MMA(1, 1, At, B1); PG_BAR;
            PG_LDB(B0, 1, 0); PG_SCHED; PG_LDA(At, 1, 0); PG_STAGE(PG_SA(0, 1), a2, sA[1]);
            PG_WAIT_L(8); PG_BAR; PG_WAIT_L(0); PG_MMA(0, 0, At, B0); PG_BAR; PG_SCHED;
            PG_LDB(B1, 1, 1); PG_STAGE(PG_SB(1, 0), b3, vB[0]);
            PG_BAR; PG_WAIT_L(0); PG_MMA(0, 1, At, B1); PG_BAR;
            PG_LDA(At, 1, 1); PG_STAGE(PG_SA(1, 0), a3, sA[0]);
            PG_BAR; PG_WAIT_L(0); PG_MMA(1, 0, At, B0); PG_BAR; PG_SCHED;
            PG_STAGE(PG_SB(1, 1), b3, vB[1]);
            PG_WAIT_V(6); PG_BAR; PG_MMA(1, 1, At, B1); PG_BAR;
        }
        E(acc, cur, wr, wc, fr, fq);
        if (!has_next) break;
#pragma unroll
        for (int a = 0; a < 2; ++a)
#pragma unroll
            for (int b = 0; b < 2; ++b)
#pragma unroll
                for (int m = 0; m < 4; ++m)
#pragma unroll
                    for (int n = 0; n < 2; ++n) acc[a][b][m][n] = (f32x4){0.f, 0.f, 0.f, 0.f};
        cur = nxt; cA = nA; cB = nB; ++ui;
#pragma unroll
        for (int h = 0; h < 2; ++h)
#pragma unroll
            for (int i = 0; i < 2; ++i) vA[h][i] = nvA[h][i];
    }
    PG_WAIT_V(0);
    if (wr == 0) PG_BAR;
    PG_BAR;
#undef PG_SA
#undef PG_SB
#undef PG_STAGE
#undef PG_LDA
#undef PG_LDB
#undef PG_MMA
#undef PG_WAIT_V
#undef PG_WAIT_L
#undef PG_BAR
#undef PG_SCHED
#undef PG_CALC_VA
}

struct DenseSched {
    static constexpr bool GATHER = false;
    const char* A; const char* Bt; size_t a_tile, b_tile; int nM, nN, nwg, G, c, rep;
    __device__ void init(const void* A_, const void* Bt_, int M, int N, int lda, int ldb, int G_, int c_) {
        rep = 1; A = (const char*)A_; Bt = (const char*)Bt_; a_tile = (size_t)BM * lda * 2; b_tile = (size_t)BM * ldb * 2; nM = M / BM; nN = N / BM; nwg = nM * nN; G = G_; c = c_; }
    __device__ __forceinline__ bool next(int i, Unit& u) const {
        const long L = (long)i * G + c; if (L >= (long)nwg * rep) return false;
        int wgid = (int)(L % nwg); { const int q = nwg / 8, r = nwg % 8, xcd = wgid % 8, off = wgid / 8; wgid = (xcd < r ? xcd * (q + 1) : r * (q + 1) + (xcd - r) * q) + off; }
        const int nig = 8 * nN, gid = wgid / nig, fm = gid * 8, gsz = (nM - fm) < 8 ? (nM - fm) : 8;
        u.pm = fm + ((wgid % nig) % gsz); u.pn = (wgid % nig) / gsz; u.g = 0; u.aux = 0; return true;
    }
    __device__ __forceinline__ const char* a_base(const Unit& u) const { return A + (size_t)u.pm * a_tile; }
    __device__ __forceinline__ const char* b_base(const Unit& u) const { return Bt + (size_t)u.pn * b_tile; }
    __device__ __forceinline__ int a_row(const Unit&, int r) const { return r; }
};
struct GroupSched {
    static constexpr bool GATHER = false;
    const char* A; const char* Bt; size_t a_tile, b_tile, a_gs, b_gs; int nM, nN, nwg, G, c, rep;
    __device__ void init(const void* A_, const void* Bt_, int NG, int Mg, int Ng, int lda, int ldb, size_t a_gstride, size_t b_gstride, int G_, int c_) {
        rep = 1; A = (const char*)A_; Bt = (const char*)Bt_; a_tile = (size_t)BM * lda * 2; b_tile = (size_t)BM * ldb * 2; a_gs = a_gstride; b_gs = b_gstride;
        nM = Mg / BM; nN = Ng / BM; nwg = NG * nM * nN; G = G_; c = c_; }
    __device__ __forceinline__ bool next(int i, Unit& u) const {
        const long L = (long)i * G + c; if (L >= (long)nwg * rep) return false;
        const int l = (int)(L % nwg); u.pn = l % nN; const int r = l / nN; u.pm = r % nM; u.g = r / nM; u.aux = 0; return true;
    }
    __device__ __forceinline__ const char* a_base(const Unit& u) const { return A + (size_t)u.g * a_gs + (size_t)u.pm * a_tile; }
    __device__ __forceinline__ const char* b_base(const Unit& u) const { return Bt + (size_t)u.g * b_gs + (size_t)u.pn * b_tile; }
    __device__ __forceinline__ int a_row(const Unit&, int r) const { return r; }
};
}

namespace ep {
using pg::Unit;
template <bool SRCF32>
struct Resid {
    static constexpr bool PERM = true;
    const void* src; bf16_t* dst_; int ld; bf16_t* dummy;
    __device__ __forceinline__ void operator()(const f32x4 (&acc)[2][2][4][2], const Unit& u, int wr, int wc, int fr, int fq) const {
        const int row0 = u.pm * 256 + wr * 64 + fr, col0 = u.pn * 256 + wc * 32 + 8 * fq; bf16_t* dst = u.aux ? dummy : dst_;
        if (SRCF32) { const float* sf = (const float*)src;
#pragma unroll
            for (int ai = 0; ai < 2; ++ai) { f32x4 b[4][2][2];
#pragma unroll
                for (int m = 0; m < 4; ++m) { const size_t off = (size_t)(row0 + ai * 128 + m * 16) * ld + col0;
#pragma unroll
                    for (int bj = 0; bj < 2; ++bj)
#pragma unroll
                        for (int n = 0; n < 2; ++n) b[m][bj][n] = *(const f32x4*)(sf + off + bj * 128 + n * 4); }
#pragma unroll
                for (int m = 0; m < 4; ++m) { const size_t off = (size_t)(row0 + ai * 128 + m * 16) * ld + col0;
#pragma unroll
                    for (int bj = 0; bj < 2; ++bj) { const f32x4 v0 = b[m][bj][0] + acc[ai][bj][m][0], v1 = b[m][bj][1] + acc[ai][bj][m][1];
                        u32x4 w; w.x = cvt_pk_bf16(v0[0], v0[1]); w.y = cvt_pk_bf16(v0[2], v0[3]); w.z = cvt_pk_bf16(v1[0], v1[1]); w.w = cvt_pk_bf16(v1[2], v1[3]);
                        *(u32x4*)(dst + off + bj * 128) = w; } } }
        } else { const bf16_t* sb = (const bf16_t*)src; u32x4 b[8][2];
#pragma unroll
            for (int q = 0; q < 8; ++q) { const size_t off = (size_t)(row0 + (q >> 2) * 128 + (q & 3) * 16) * ld + col0; b[q][0] = *(const u32x4*)(sb + off); b[q][1] = *(const u32x4*)(sb + off + 128); }
#pragma unroll
            for (int ai = 0; ai < 2; ++ai)
#pragma unroll
                for (int m = 0; m < 4; ++m) { const size_t off = (size_t)(row0 + ai * 128 + m * 16) * ld + col0;
#pragma unroll
                    for (int bj = 0; bj < 2; ++bj) { const u32x4 x = b[ai * 4 + m][bj]; const f32x4 a0 = acc[ai][bj][m][0], a1 = acc[ai][bj][m][1];
                        u32x4 w; w.x = cvt_pk_bf16(bflo(x.x) + a0[0], bfhi(x.x) + a0[1]); w.y = cvt_pk_bf16(bflo(x.y) + a0[2], bfhi(x.y) + a0[3]);
                        w.z = cvt_pk_bf16(bflo(x.z) + a1[0], bfhi(x.z) + a1[1]); w.w = cvt_pk_bf16(bflo(x.w) + a1[2], bfhi(x.w) + a1[3]);
                        *(u32x4*)(dst + off + bj * 128) = w; } }
        }
    }
};
struct LruIn {
    static constexpr bool PERM = true;
    bf16_t* gate; bf16_t* xrp; const float* rs;
    __device__ __forceinline__ void operator()(const f32x4 (&acc)[2][2][4][2], const Unit& u, int wr, int wc, int fr, int fq) const {
        const int row0 = u.pm * 256 + wr * 64 + fr; const bool isg = (u.pn < 8); const int col0 = (u.pn & 7) * 256 + wc * 32 + 8 * fq;
        bf16_t* base = isg ? gate : xrp; float rv[8];
#pragma unroll
        for (int q = 0; q < 8; ++q) rv[q] = rs[row0 + (q >> 2) * 128 + (q & 3) * 16];
#pragma unroll
        for (int ai = 0; ai < 2; ++ai)
#pragma unroll
            for (int m = 0; m < 4; ++m) { bf16_t* rowp = base + (size_t)(row0 + ai * 128 + m * 16) * 2048 + col0;
#pragma unroll
                for (int bj = 0; bj < 2; ++bj) { f32x4 v0 = acc[ai][bj][m][0] * rv[ai * 4 + m], v1 = acc[ai][bj][m][1] * rv[ai * 4 + m];
                    if (isg) { const f32x2 a = gelu_tanh_2(LO2(v0)), b = gelu_tanh_2(HI2(v0)), c = gelu_tanh_2(LO2(v1)), d = gelu_tanh_2(HI2(v1));
                        v0 = (f32x4){a[0], a[1], b[0], b[1]}; v1 = (f32x4){c[0], c[1], d[0], d[1]}; }
                    u32x4 w; w.x = cvt_pk_bf16(v0[0], v0[1]); w.y = cvt_pk_bf16(v0[2], v0[3]); w.z = cvt_pk_bf16(v1[0], v1[1]); w.w = cvt_pk_bf16(v1[2], v1[3]);
                    *(u32x4*)(rowp + bj * 128) = w; } }
    }
};
struct LruGates {
    static constexpr bool PERM = false;
    const bf16_t* xr; const float* b_a; const float* b_x; const float* spt; unsigned* LAB;
    __device__ __forceinline__ void operator()(const f32x4 (&acc)[2][2][4][2], const Unit& u, int wr, int wc, int fr, int fq) const {
        int fr_ = fr, fq_ = fq; asm volatile("" : "+v"(fr_), "+v"(fq_));
        const int dir = u.pn >> 1; const int row0 = u.pm * 256 + wr * 64 + fr_;
        const int ch0 = u.g * 256 + 128 * (u.pn & 1) + 16 * wc + 4 * fq_;
        f32x4 ba[2], bx[2], sp[2]; u32x2 xw[2][8];
#pragma unroll
        for (int bj = 0; bj < 2; ++bj) { const int ch = ch0 + 64 * bj; ba[bj] = *(const f32x4*)(b_a + dir * 2048 + ch); bx[bj] = *(const f32x4*)(b_x + dir * 2048 + ch); sp[bj] = *(const f32x4*)(spt + dir * 2048 + ch);
#pragma unroll
            for (int q = 0; q < 8; ++q) { const int t = row0 + (q >> 2) * 128 + (q & 3) * 16; xw[bj][q] = *(const u32x2*)((const char*)xr + (unsigned)((t * 2048 + ch) * 2)); } }
        constexpr float L2E = 1.4426950408889634f;
#pragma unroll
        for (int bj = 0; bj < 2; ++bj) { const int ch = ch0 + 64 * bj;
            f32x2 nba[2], nbx[2], m8[2], m8l[2];
#pragma unroll
            for (int p = 0; p < 2; ++p) { nba[p] = (f32x2){ba[bj][2 * p], ba[bj][2 * p + 1]} * (-L2E); nbx[p] = (f32x2){bx[bj][2 * p], bx[bj][2 * p + 1]} * (-L2E);
                m8[p] = (f32x2){sp[bj][2 * p], sp[bj][2 * p + 1]} * (-8.0f); m8l[p] = m8[p] * L2E; }
#pragma unroll
            for (int ai = 0; ai < 2; ++ai)
#pragma unroll
                for (int m = 0; m < 4; ++m) { const int t = row0 + ai * 128 + m * 16; const u32x2 x2 = xw[bj][ai * 4 + m];
                    u32x4 pk;
#pragma unroll
                    for (int p = 0; p < 2; ++p) { const unsigned xwd = p ? x2.y : x2.x; const f32x2 xv = (f32x2){bflo(xwd), bfhi(xwd)};
                        const f32x2 ar = (f32x2){acc[ai][bj][m][0][2 * p], acc[ai][bj][m][0][2 * p + 1]}, ax = (f32x2){acc[ai][bj][m][1][2 * p], acc[ai][bj][m][1][2 * p + 1]};
                        const f32x2 er = ar * (-L2E) + nba[p], ex = ax * (-L2E) + nbx[p];
                        const f32x2 dr = (f32x2){__builtin_amdgcn_exp2f(er[0]), __builtin_amdgcn_exp2f(er[1])} + 1.0f, dx = (f32x2){__builtin_amdgcn_exp2f(ex[0]), __builtin_amdgcn_exp2f(ex[1])} + 1.0f;
                        const f32x2 r = (f32x2){__builtin_amdgcn_rcpf(dr[0]), __builtin_amdgcn_rcpf(dr[1])}, ig = (f32x2){__builtin_amdgcn_rcpf(dx[0]), __builtin_amdgcn_rcpf(dx[1])};
                        const f32x2 la = r * m8[p], lal = r * m8l[p];
                        const f32x2 aa = (f32x2){__builtin_amdgcn_exp2f(lal[0]), __builtin_amdgcn_exp2f(lal[1])};
                        const f32x2 om = 1.0f - aa * aa;
                        const f32x2 bb = (f32x2){__builtin_amdgcn_sqrtf(om[0]), __builtin_amdgcn_sqrtf(om[1])} * (ig * xv);
                        pk[2 * p] = cvt_pk_bf16(la[0], bb[0]); pk[2 * p + 1] = cvt_pk_bf16(la[1], bb[1]); }
                    const unsigned ob = (unsigned)(((dir * S_ + t) * 2048 + ch) * 4);
                    *(u32x4*)((char*)LAB + ob) = pk; } }
    }
};
struct QkvRope {
    static constexpr bool PERM = false;
    bf16_t* o0; bf16_t* o1; bf16_t* o2; int c1, c2; const float* cs; const float* rs;
    __device__ __forceinline__ void operator()(const f32x4 (&acc)[2][2][4][2], const Unit& u, int wr, int wc, int fr, int fq) const {
        const int row0 = u.pm * 256 + wr * 64 + fr; const int ct = u.pn * 256;
        bf16_t* base; int cl; bool rope;
        if (ct < c1) { base = o0; cl = ct; rope = true; } else if (ct < c2) { base = o1; cl = ct - c1; rope = true; } else { base = o2; cl = ct - c2; rope = false; }
        rope = rope && (wc == 0);
        const int head0 = cl >> 7;
        f32x4 cva[8], sva[8];
#pragma unroll
        for (int q = 0; q < 8; ++q) { const int t = row0 + (q >> 2) * 128 + (q & 3) * 16; cva[q] = (f32x4){1.f, 1.f, 1.f, 1.f}; sva[q] = (f32x4){0.f, 0.f, 0.f, 0.f};
            if (rope) { cva[q] = *(const f32x4*)(cs + (size_t)t * 32 + 4 * fq); sva[q] = *(const f32x4*)(cs + (size_t)t * 32 + 16 + 4 * fq); }
            const float rv = rs[t]; cva[q] *= rv; sva[q] *= rv; }
#pragma unroll
        for (int ai = 0; ai < 2; ++ai)
#pragma unroll
            for (int m = 0; m < 4; ++m) { const int t = row0 + ai * 128 + m * 16; bf16_t* rowp = base + ((size_t)head0 * S_ + t) * 128 + wc * 32 + 4 * fq;
                const f32x4 cv = cva[ai * 4 + m], sv = sva[ai * 4 + m];
#pragma unroll
                for (int bj = 0; bj < 2; ++bj) { const f32x4 v0 = acc[ai][bj][m][0], v1 = acc[ai][bj][m][1];
                    const f32x4 r0 = v0 * cv - v1 * sv, r1 = v1 * cv + v0 * sv;
                    u32x2 w0, w1; w0.x = cvt_pk_bf16(r0[0], r0[1]); w0.y = cvt_pk_bf16(r0[2], r0[3]); w1.x = cvt_pk_bf16(r1[0], r1[1]); w1.y = cvt_pk_bf16(r1[2], r1[3]);
                    *(u32x2*)(rowp + (size_t)bj * S_ * 128) = w0; *(u32x2*)(rowp + (size_t)bj * S_ * 128 + 16) = w1; } }
    }
};
struct S5In {
    static constexpr bool PERM = false;
    float* U; bf16_t* UA; const float* rs;
    __device__ __forceinline__ void operator()(const f32x4 (&acc)[2][2][4][2], const Unit& u, int wr, int wc, int fr, int fq) const {
        const int row0 = u.pm * 256 + wr * 64 + fr, col0 = u.pn * 256 + wc * 32 + 4 * fq; float rv[8];
#pragma unroll
        for (int q = 0; q < 8; ++q) rv[q] = rs[row0 + (q >> 2) * 128 + (q & 3) * 16];
#pragma unroll
        for (int ai = 0; ai < 2; ++ai)
#pragma unroll
            for (int m = 0; m < 4; ++m) { const int t = row0 + ai * 128 + m * 16;
#pragma unroll
                for (int bj = 0; bj < 2; ++bj)
#pragma unroll
                    for (int n = 0; n < 2; ++n) { const int col = col0 + bj * 128 + n * 16; const f32x4 v = acc[ai][bj][m][n] * rv[ai * 4 + m];
                        *(f32x4*)(U + (size_t)t * 1024 + col) = v;
                        const int g = col >> 4, chn = col & 15; u32x2 w; w.x = cvt_pk_bf16(v[0], v[1]); w.y = cvt_pk_bf16(v[2], v[3]);
                        *(u32x2*)(UA + (size_t)g * (512 * 512) + (size_t)(t >> 4) * 512 + (t & 15) * 16 + chn) = w; } }
    }
};
struct F32Group {
    static constexpr bool PERM = false;
    float* C; int ld; size_t gstride;
    __device__ __forceinline__ void operator()(const f32x4 (&acc)[2][2][4][2], const Unit& u, int wr, int wc, int fr, int fq) const {
        const int row0 = u.pm * 256 + wr * 64 + fr, col0 = u.pn * 256 + wc * 32 + 4 * fq; float* Cg = C + (size_t)u.g * gstride;
#pragma unroll
        for (int ai = 0; ai < 2; ++ai)
#pragma unroll
            for (int m = 0; m < 4; ++m) { float* rowp = Cg + (size_t)(row0 + ai * 128 + m * 16) * ld + col0;
#pragma unroll
                for (int bj = 0; bj < 2; ++bj)
#pragma unroll
                    for (int n = 0; n < 2; ++n) *(f32x4*)(rowp + bj * 128 + n * 16) = acc[ai][bj][m][n]; }
    }
};
struct S5Y {
    static constexpr bool PERM = false;
    const float* U; const float* dsk; bf16_t* G;
    __device__ __forceinline__ void operator()(const f32x4 (&acc)[2][2][4][2], const Unit& u, int wr, int wc, int fr, int fq) const {
        const int row0 = u.pm * 256 + wr * 64 + fr; const int ch = 16 * u.g + 4 * fq;
        const f32x4 dv = *(const f32x4*)(dsk + ch);
#pragma unroll
        for (int ai = 0; ai < 2; ++ai) { f32x4 uv[4][2][2];
#pragma unroll
            for (int m = 0; m < 4; ++m) { const int c = row0 + ai * 128 + m * 16;
#pragma unroll
                for (int bj = 0; bj < 2; ++bj)
#pragma unroll
                    for (int n = 0; n < 2; ++n) { const int t = 16 * c + 8 * bj + 2 * wc + n; uv[m][bj][n] = *(const f32x4*)(U + (size_t)t * 1024 + ch); } }
#pragma unroll
            for (int m = 0; m < 4; ++m) { const int c = row0 + ai * 128 + m * 16;
#pragma unroll
                for (int bj = 0; bj < 2; ++bj)
#pragma unroll
                    for (int n = 0; n < 2; ++n) { const int t = 16 * c + 8 * bj + 2 * wc + n; const f32x4 y = acc[ai][bj][m][n] + dv * uv[m][bj][n];
                        const f32x2 ga = gelu_tanh_2(LO2(y)), gb = gelu_tanh_2(HI2(y));
                        u32x2 w; w.x = cvt_pk_bf16(ga[0], ga[1]); w.y = cvt_pk_bf16(gb[0], gb[1]);
                        *(u32x2*)(G + (size_t)t * 1024 + ch) = w; } } }
    }
};
struct S5Glu {
    static constexpr bool PERM = true;
    const bf16_t* G; bf16_t* Z;
    __device__ __forceinline__ void operator()(const f32x4 (&acc)[2][2][4][2], const Unit& u, int wr, int wc, int fr, int fq) const {
        const int row0 = u.pm * 256 + wr * 64 + fr, col0 = u.pn * 256 + wc * 32 + 8 * fq;
        u32x4 gwa[8][2];
#pragma unroll
        for (int q = 0; q < 8; ++q) { const size_t off = (size_t)(row0 + (q >> 2) * 128 + (q & 3) * 16) * 1024 + col0; gwa[q][0] = *(const u32x4*)(G + off); gwa[q][1] = *(const u32x4*)(G + off + 128); }
#pragma unroll
        for (int ai = 0; ai < 2; ++ai)
#pragma unroll
            for (int m = 0; m < 4; ++m) { const size_t off = (size_t)(row0 + ai * 128 + m * 16) * 1024 + col0;
#pragma unroll
                for (int bj = 0; bj < 2; ++bj) { const f32x4 v0 = acc[ai][bj][m][0], v1 = acc[ai][bj][m][1];
                    const u32x4 gw = gwa[ai * 4 + m][bj];
                    const float g0 = bflo(gw.x), g1 = bfhi(gw.x), g2 = bflo(gw.y), g3 = bfhi(gw.y), g4 = bflo(gw.z), g5 = bfhi(gw.z), g6 = bflo(gw.w), g7 = bfhi(gw.w);
                    const f32x2 za = (f32x2){g0, g1} * sigmoid_2(LO2(v0)), zb = (f32x2){g2, g3} * sigmoid_2(HI2(v0)), zc = (f32x2){g4, g5} * sigmoid_2(LO2(v1)), zd = (f32x2){g6, g7} * sigmoid_2(HI2(v1));
                    u32x4 w; w.x = cvt_pk_bf16(za[0], za[1]); w.y = cvt_pk_bf16(zb[0], zb[1]); w.z = cvt_pk_bf16(zc[0], zc[1]); w.w = cvt_pk_bf16(zd[0], zd[1]);
                    *(u32x4*)(Z + off + bj * 128) = w; } }
    }
};
struct MoeGU {
    static constexpr bool PERM = false;
    bf16_t* hdn; const float* rsg; const LAS int* lc;
    __device__ __forceinline__ void operator()(const f32x4 (&acc)[2][2][4][2], const Unit& u, int wr, int wc, int fr, int fq) const {
        const int row0 = u.aux * 256 + wr * 64 + fr; const int j0 = 128 * u.pn + 16 * wc + 4 * fq; float rv[8];
        { const int cnt = lc[u.g], i0 = u.pm * 256 + wr * 64 + fr;
#pragma unroll
          for (int q = 0; q < 8; ++q) { const int idx = i0 + (q >> 2) * 128 + (q & 3) * 16; rv[q] = (idx < cnt) ? rsg[u.g * 8192 + idx] : 0.f; } }
#pragma unroll
        for (int ai = 0; ai < 2; ++ai)
#pragma unroll
            for (int m = 0; m < 4; ++m) { bf16_t* rowp = hdn + (size_t)(row0 + ai * 128 + m * 16) * 512 + j0;
#pragma unroll
                for (int bj = 0; bj < 2; ++bj) { const f32x4 g = acc[ai][bj][m][0] * rv[ai * 4 + m], up = acc[ai][bj][m][1] * rv[ai * 4 + m]; float h[4];
                    { const f32x2 a = LO2(g) * sigmoid_2(LO2(g)) * LO2(up), b = HI2(g) * sigmoid_2(HI2(g)) * HI2(up); h[0] = a[0]; h[1] = a[1]; h[2] = b[0]; h[3] = b[1]; }
                    u32x2 w; w.x = cvt_pk_bf16(h[0], h[1]); w.y = cvt_pk_bf16(h[2], h[3]);
                    *(u32x2*)(rowp + bj * 64) = w; } }
    }
};
struct MoeDown {
    static constexpr bool PERM = true;
    bf16_t* ys;
    __device__ __forceinline__ void operator()(const f32x4 (&acc)[2][2][4][2], const Unit& u, int wr, int wc, int fr, int fq) const {
        const int row0 = u.aux * 256 + wr * 64 + fr, col0 = u.pn * 256 + wc * 32 + 8 * fq;
#pragma unroll
        for (int ai = 0; ai < 2; ++ai)
#pragma unroll
            for (int m = 0; m < 4; ++m) { bf16_t* rowp = ys + (size_t)(row0 + ai * 128 + m * 16) * 2048 + col0;
#pragma unroll
                for (int bj = 0; bj < 2; ++bj) { const f32x4 v0 = acc[ai][bj][m][0], v1 = acc[ai][bj][m][1];
                    u32x4 w; w.x = cvt_pk_bf16(v0[0], v0[1]); w.y = cvt_pk_bf16(v0[2], v0[3]); w.z = cvt_pk_bf16(v1[0], v1[1]); w.w = cvt_pk_bf16(v1[2], v1[3]);
                    *(u32x4*)(rowp + bj * 128) = w; } }
    }
};
}

namespace att {
constexpr int D = 128, NW = 8, QBLK = 32, KVBLK = 64;
constexpr float SCALE = 0.088388347648318440f;
constexpr float THR = 8.f;
constexpr int SHM_V = KVBLK * D * 2, SHM_K = KVBLK * D * 2, SHM_ATTN = 2 * SHM_V + 2 * SHM_K + NW * 64 * 4;
#define KSWZ(row, colB) ((row) * 256 + ((colB) ^ (((row) & 7) << 4)))
#define SBAR() __builtin_amdgcn_sched_barrier(0)
__device__ __forceinline__ int crow(int r, int hi) { return (r & 3) + 8 * (r >> 2) + 4 * hi; }
__device__ __forceinline__ void partialSM(f32x16& p0, f32x16& p1, float& m_reg, float& mn, float& alpha) {
    constexpr float C = SCALE * 1.4426950408889634f;
    float pmax = p0[0];
#pragma unroll
    for (int r = 1; r < 16; ++r) pmax = fmaxf(pmax, p0[r]);
#pragma unroll
    for (int r = 0; r < 16; ++r) pmax = fmaxf(pmax, p1[r]);
    { auto rr = __builtin_amdgcn_permlane32_swap(__float_as_uint(pmax), __float_as_uint(pmax), false, false);
      pmax = fmaxf(__uint_as_float(rr[0]), __uint_as_float(rr[1])); }
    if (__builtin_expect(__all(pmax - m_reg <= THR / SCALE), 1)) { mn = m_reg; alpha = 1.f; }
    else { mn = fmaxf(m_reg, pmax); alpha = __builtin_amdgcn_exp2f((m_reg - mn) * C); m_reg = mn; }
    const float mnC = -mn * C;
#pragma unroll
    for (int r = 0; r < 16; ++r) p0[r] = fmaf(p0[r], C, mnC);
#pragma unroll
    for (int r = 0; r < 16; ++r) p1[r] = fmaf(p1[r], C, mnC);
#pragma unroll
    for (int r = 0; r < 16; ++r) p0[r] = __builtin_amdgcn_exp2f(p0[r]);
}
__device__ __forceinline__ void finishSM(f32x16& p0, f32x16& p1, float alpha, float& l_reg, bf16x8& pa0, bf16x8& pa1, bf16x8& pa2, bf16x8& pa3) {
#pragma unroll
    for (int r = 0; r < 16; ++r) p1[r] = __builtin_amdgcn_exp2f(p1[r]);
    float ps = 0;
#pragma unroll
    for (int r = 0; r < 16; ++r) ps += p0[r];
#pragma unroll
    for (int r = 0; r < 16; ++r) ps += p1[r];
    { auto rr = __builtin_amdgcn_permlane32_swap(__float_as_uint(ps), __float_as_uint(ps), false, false);
      ps = __uint_as_float(rr[0]) + __uint_as_float(rr[1]); }
    l_reg = l_reg * alpha + ps;
#define PK4(P, BASE, OUT) do { unsigned a0 = cvt_pk_bf16(P[BASE + 0], P[BASE + 1]), a1 = cvt_pk_bf16(P[BASE + 2], P[BASE + 3]);   \
    unsigned b0 = cvt_pk_bf16(P[BASE + 4], P[BASE + 5]), b1 = cvt_pk_bf16(P[BASE + 6], P[BASE + 7]);                              \
    auto r0 = __builtin_amdgcn_permlane32_swap(a0, b0, false, false); auto r1 = __builtin_amdgcn_permlane32_swap(a1, b1, false, false); \
    u32x4 w = {r0[0], r1[0], r0[1], r1[1]}; OUT = *reinterpret_cast<bf16x8*>(&w); } while (0)
    PK4(p0, 0, pa0); PK4(p0, 8, pa1); PK4(p1, 0, pa2); PK4(p1, 8, pa3);
#undef PK4
}
__device__ __forceinline__ void qkt(f32x16& p0, f32x16& p1, const LAS char* Ks, const bf16x8* qr, int r32, int hi) {
    p0 = f32x16{}; p1 = f32x16{};
#pragma unroll
    for (int d0 = 0; d0 < 8; ++d0) { const int cb = (d0 * 16 + hi * 8) * 2;
        const bf16x8 b0 = *reinterpret_cast<const LAS bf16x8*>(Ks + KSWZ(r32, cb));
        const bf16x8 b1 = *reinterpret_cast<const LAS bf16x8*>(Ks + KSWZ(32 + r32, cb));
        p0 = __builtin_amdgcn_mfma_f32_32x32x16_bf16(b0, qr[d0], p0, 0, 0, 0);
        p1 = __builtin_amdgcn_mfma_f32_32x32x16_bf16(b1, qr[d0], p1, 0, 0, 0); }
}
__device__ __forceinline__ void qkt4(f32x16& p0, f32x16& p1, const LAS char* Ks, const bf16x8* qr, const int (&ka)[4]) {
    p0 = f32x16{}; p1 = f32x16{};
#pragma unroll
    for (int d0 = 0; d0 < 8; ++d0) { const LAS char* a = Ks + ka[d0 & 3] + (d0 >> 2) * 128;
        const bf16x8 b0 = *reinterpret_cast<const LAS bf16x8*>(a);
        const bf16x8 b1 = *reinterpret_cast<const LAS bf16x8*>(a + 8192);
        p0 = __builtin_amdgcn_mfma_f32_32x32x16_bf16(b0, qr[d0], p0, 0, 0, 0);
        p1 = __builtin_amdgcn_mfma_f32_32x32x16_bf16(b1, qr[d0], p1, 0, 0, 0); }
}
__device__ __forceinline__ void wmask(f32x16& p0, f32x16& p1, int dbase, int hi) {
#pragma unroll
    for (int r = 0; r < 16; ++r) { const int d0 = dbase + crow(r, hi), d1 = d0 + 32;
        p0[r] = (d0 >= -128 && d0 <= 128) ? p0[r] : -1e30f; p1[r] = (d1 >= -128 && d1 <= 128) ? p1[r] : -1e30f; }
}
__device__ __forceinline__ int v_st(int k, int c) { const int kk = (k & ~0xC) | ((k & 4) << 1) | ((k & 8) >> 1); return ((kk >> 3) * 4 + (c >> 5)) * 512 + ((kk & 7) * 32 + (c & 31)) * 2; }
__device__ __forceinline__ int v_rd_base(int lane) { return ((lane & 3) << 3) | (((lane >> 2) & 3) << 6) | (((lane >> 4) & 1) << 5) | (((lane >> 5) & 1) << 8); }
constexpr int v_rd_off(int d0, int ks, int half) { return d0 * 512 + ks * 4096 + half * 2048; }
template <int OFF> __device__ __forceinline__ s16x4 tr_read(int vb) {
    s16x4 r; asm volatile("ds_read_b64_tr_b16 %0, %1 offset:%2" : "=&v"(r) : "v"(vb), "i"(OFF) : "memory"); return r;
}
template <int D0> __device__ __forceinline__ void pv_one(f32x16& od, int vb, bf16x8 pa0, bf16x8 pa1, bf16x8 pa2, bf16x8 pa3) {
    const s16x4 l0 = tr_read<v_rd_off(D0, 0, 0)>(vb), h0 = tr_read<v_rd_off(D0, 0, 1)>(vb), l1 = tr_read<v_rd_off(D0, 1, 0)>(vb), h1 = tr_read<v_rd_off(D0, 1, 1)>(vb);
    const s16x4 l2 = tr_read<v_rd_off(D0, 2, 0)>(vb), h2 = tr_read<v_rd_off(D0, 2, 1)>(vb), l3 = tr_read<v_rd_off(D0, 3, 0)>(vb), h3 = tr_read<v_rd_off(D0, 3, 1)>(vb);
    asm volatile("s_waitcnt lgkmcnt(0)" ::: "memory"); SBAR();
#define PK(L, H) (bf16x8){L[0], L[1], L[2], L[3], H[0], H[1], H[2], H[3]}
    od = __builtin_amdgcn_mfma_f32_32x32x16_bf16(pa0, PK(l0, h0), od, 0, 0, 0);
    od = __builtin_amdgcn_mfma_f32_32x32x16_bf16(pa1, PK(l1, h1), od, 0, 0, 0);
    od = __builtin_amdgcn_mfma_f32_32x32x16_bf16(pa2, PK(l2, h2), od, 0, 0, 0);
    od = __builtin_amdgcn_mfma_f32_32x32x16_bf16(pa3, PK(l3, h3), od, 0, 0, 0);
#undef PK
}
__device__ __forceinline__ void pv_d0(f32x16* o, int vb, bf16x8 pa0, bf16x8 pa1, bf16x8 pa2, bf16x8 pa3) {
    pv_one<0>(o[0], vb, pa0, pa1, pa2, pa3); pv_one<1>(o[1], vb, pa0, pa1, pa2, pa3); pv_one<2>(o[2], vb, pa0, pa1, pa2, pa3); pv_one<3>(o[3], vb, pa0, pa1, pa2, pa3);
}
template <int LDQ, int LDK, int LDV, int LDO, bool MASK, int NTC>
__device__ __forceinline__ void body(const bf16_t* __restrict__ Qb, const bf16_t* __restrict__ Kh, const bf16_t* __restrict__ Vh, bf16_t* __restrict__ Ob, const int NTR,
                                     LAS char* lds, const int qpos0, const int kpos0, const float sink_raw, const int tid_in) {
    int tid_ = tid_in; asm volatile("" : "+v"(tid_));
    const int tid = tid_, wid = tid >> 6, lane = tid & 63, r32 = lane & 31, hi = lane >> 5; const int NT = NTC ? NTC : NTR;
    LAS char* V_lds = lds; LAS char* K_lds = lds + 2 * SHM_V;
    LAS float* ws = (LAS float*)(lds + 2 * SHM_V + 2 * SHM_K) + wid * 64; LAS float* li_l = ws; LAS float* al_l = ws + 32;
    float m_reg = MASK ? sink_raw : -1e30f, l_reg = MASK ? 1.f : 0.f; f32x16 o[4] = {}; bf16x8 qr[8];
    const bf16_t* Qw = Qb + (long)(wid * QBLK + r32) * LDQ + hi * 8;
#pragma unroll
    for (int d0 = 0; d0 < 8; ++d0) qr[d0] = *reinterpret_cast<const bf16x8*>(Qw + d0 * 16);
    const int sr = tid >> 4, sc = (tid & 15) * 8, vst0 = v_st(sr, sc), vst1 = v_st(32 + sr, sc);
    const int vb0 = (int)(uintptr_t)V_lds + v_rd_base(lane);
    const int dq = kpos0 - (qpos0 + wid * QBLK + r32);
    struct { bf16x8 vs0, vs1, ks0, ks1; } sr_[2];
#define SLOAD(i, k0) do { sr_[i].vs0 = *reinterpret_cast<const bf16x8*>(&Vh[(long)((k0) + sr) * LDV + sc]); sr_[i].vs1 = *reinterpret_cast<const bf16x8*>(&Vh[(long)((k0) + 32 + sr) * LDV + sc]); \
    sr_[i].ks0 = *reinterpret_cast<const bf16x8*>(&Kh[(long)((k0) + sr) * LDK + sc]); sr_[i].ks1 = *reinterpret_cast<const bf16x8*>(&Kh[(long)((k0) + 32 + sr) * LDK + sc]); } while (0)
#define SWRITE(b, i) do { *(LAS bf16x8*)(V_lds + (b) * SHM_V + vst0) = sr_[i].vs0;          \
    *(LAS bf16x8*)(V_lds + (b) * SHM_V + vst1) = sr_[i].vs1; const int kc = sc * 2;               \
    *(LAS bf16x8*)(K_lds + (b) * SHM_K + KSWZ(sr, kc)) = sr_[i].ks0;                       \
    *(LAS bf16x8*)(K_lds + (b) * SHM_K + KSWZ(32 + sr, kc)) = sr_[i].ks1; } while (0)
#define SWAIT() asm volatile("s_waitcnt vmcnt(4)" ::: "memory")
#define RESC(a) do { if (__any((a) < 1.f)) { if (hi == 0) al_l[r32] = (a); asm volatile("s_waitcnt lgkmcnt(0)" ::: "memory"); \
    _Pragma("unroll") for (int d = 0; d < 4; ++d) _Pragma("unroll") for (int r = 0; r < 16; ++r) o[d][r] *= al_l[crow(r, hi)]; } } while (0)
    f32x16 pA0, pA1, pB0, pB1; float mnA, mnB, alA, alB; bf16x8 pa0, pa1, pa2, pa3;
    constexpr int SE = 0, SO = 1;
    SLOAD(SE, 0); asm volatile("s_waitcnt vmcnt(0)" ::: "memory"); SWRITE(0, SE); __syncthreads();
    qkt(pA0, pA1, K_lds, qr, r32, hi); if (MASK) wmask(pA0, pA1, dq, hi); partialSM(pA0, pA1, m_reg, mnA, alA);
    SLOAD(SO, KVBLK); if (2 < NT) SLOAD(SE, 2 * KVBLK);
    SWAIT(); SWRITE(1, SO); __syncthreads();
    for (int j = 1; j + 1 < NT; j += 2) {
        SBAR(); qkt(pB0, pB1, K_lds + SHM_K, qr, r32, hi); if (MASK) wmask(pB0, pB1, dq + j * KVBLK, hi);
        finishSM(pA0, pA1, alA, l_reg, pa0, pa1, pa2, pa3); SBAR();
        SLOAD(SO, (j + 2) * KVBLK); SBAR();
        pv_d0(o, vb0, pa0, pa1, pa2, pa3); partialSM(pB0, pB1, m_reg, mnB, alB);
        __syncthreads(); SWAIT(); SWRITE(0, SE);
        RESC(alB); __syncthreads();
        SBAR(); qkt(pA0, pA1, K_lds, qr, r32, hi); if (MASK) wmask(pA0, pA1, dq + (j + 1) * KVBLK, hi);
        finishSM(pB0, pB1, alB, l_reg, pa0, pa1, pa2, pa3); SBAR();
        if (j + 3 < NT) SLOAD(SE, (j + 3) * KVBLK); SBAR();
        pv_d0(o, vb0 + SHM_V, pa0, pa1, pa2, pa3); partialSM(pA0, pA1, m_reg, mnA, alA);
        __syncthreads(); SWAIT(); SWRITE(1, SO);
        RESC(alA); __syncthreads();
    }
    SBAR(); qkt(pB0, pB1, K_lds + SHM_K, qr, r32, hi); if (MASK) wmask(pB0, pB1, dq + (NT - 1) * KVBLK, hi);
    finishSM(pA0, pA1, alA, l_reg, pa0, pa1, pa2, pa3); SBAR();
    pv_d0(o, vb0, pa0, pa1, pa2, pa3); partialSM(pB0, pB1, m_reg, mnB, alB);
    __syncthreads(); RESC(alB);
    finishSM(pB0, pB1, alB, l_reg, pa0, pa1, pa2, pa3); SBAR();
    pv_d0(o, vb0 + SHM_V, pa0, pa1, pa2, pa3);
    if (hi == 0) li_l[r32] = l_reg; asm volatile("s_waitcnt lgkmcnt(0)" ::: "memory");
    float rli[16];
#pragma unroll
    for (int r = 0; r < 16; ++r) rli[r] = __builtin_amdgcn_rcpf(li_l[crow(r, hi)]);
    bf16_t* Ow = Ob + (long)(wid * QBLK) * LDO;
#pragma unroll
    for (int r = 0; r < 16; ++r) { const int orow = crow(r, hi);
#pragma unroll
        for (int d0 = 0; d0 < 4; ++d0) Ow[(long)orow * LDO + d0 * 32 + r32] = f2bf(o[d0][r] * rli[r]); }
    __syncthreads();
#undef SLOAD
#undef SWRITE
#undef SWAIT
#undef RESC
}

template <int G> struct PvG { static constexpr int vh = G >> 2, d0 = G & 3, base = vh * 16384 + d0 * 512; };
#define PVG_RD(G, X) do { X##0 = tr_read<PvG<G>::base>(vb); X##1 = tr_read<PvG<G>::base + 2048>(vb); X##2 = tr_read<PvG<G>::base + 4096>(vb); X##3 = tr_read<PvG<G>::base + 6144>(vb); \
    X##4 = tr_read<PvG<G>::base + 8192>(vb); X##5 = tr_read<PvG<G>::base + 10240>(vb); X##6 = tr_read<PvG<G>::base + 12288>(vb); X##7 = tr_read<PvG<G>::base + 14336>(vb); } while (0)
#define PVG_PK(L, H) (bf16x8){L[0], L[1], L[2], L[3], H[0], H[1], H[2], H[3]}
#define PVG_MM(G, X) do { o[G] = __builtin_amdgcn_mfma_f32_32x32x16_bf16(pa0, PVG_PK(X##0, X##1), o[G], 0, 0, 0); o[G] = __builtin_amdgcn_mfma_f32_32x32x16_bf16(pa1, PVG_PK(X##2, X##3), o[G], 0, 0, 0); \
    o[G] = __builtin_amdgcn_mfma_f32_32x32x16_bf16(pa2, PVG_PK(X##4, X##5), o[G], 0, 0, 0); o[G] = __builtin_amdgcn_mfma_f32_32x32x16_bf16(pa3, PVG_PK(X##6, X##7), o[G], 0, 0, 0); } while (0)
#define PVG_W8() do { asm volatile("s_waitcnt lgkmcnt(8)" ::: "memory"); SBAR(); } while (0)
__device__ __forceinline__ void pv_pipe8(f32x16 (&o)[8], const int vb, const bf16x8 pa0, const bf16x8 pa1, const bf16x8 pa2, const bf16x8 pa3) {
    s16x4 a0, a1, a2, a3, a4, a5, a6, a7, b0, b1, b2, b3, b4, b5, b6, b7;
    PVG_RD(0, a);
    PVG_RD(1, b); PVG_W8(); PVG_MM(0, a);
    PVG_RD(2, a); PVG_W8(); PVG_MM(1, b);
    PVG_RD(3, b); PVG_W8(); PVG_MM(2, a);
    PVG_RD(4, a); PVG_W8(); PVG_MM(3, b);
    PVG_RD(5, b); PVG_W8(); PVG_MM(4, a);
    PVG_RD(6, a); PVG_W8(); PVG_MM(5, b);
    PVG_RD(7, b); PVG_W8(); PVG_MM(6, a);
    asm volatile("s_waitcnt lgkmcnt(0)" ::: "memory"); SBAR(); PVG_MM(7, b);
}
#undef PVG_RD
#undef PVG_PK
#undef PVG_MM
#undef PVG_W8

constexpr int B2_V = 0, B2_K = 65536, B2_WS = 98304, B2_LAM = B2_WS + NW * 256, SHM_ATTN2 = B2_LAM + 16;
template <int LDQ, int LDK, int LDV, int LDO, int EPI>
__device__ __forceinline__ void body2(const bf16_t* __restrict__ Qb, const bf16_t* __restrict__ Kh, const bf16_t* __restrict__ Vlo, const bf16_t* __restrict__ Vhi,
                                      bf16_t* __restrict__ Ob, const int NT, LAS char* lds, const int tid_in, float* __restrict__ Oscr, const float lam, const float* __restrict__ gsub, const float post) {
    int tid_ = tid_in; asm volatile("" : "+v"(tid_));
    const int tid = tid_, wid = __builtin_amdgcn_readfirstlane(tid >> 6), lane = tid & 63, r32 = lane & 31, hi = lane >> 5; const bool halfA = wid < 4;
    LAS float* ws = (LAS float*)(lds + B2_WS) + wid * 64; LAS float* li_l = ws; LAS float* al_l = ws + 32;
    float m_reg = -1e30f, l_reg = 0.f; f32x16 o[8] = {}; bf16x8 qr[8];
    const bf16_t* Qw = Qb + (long)(wid * QBLK + r32) * LDQ + hi * 8;
#pragma unroll
    for (int d0 = 0; d0 < 8; ++d0) qr[d0] = *reinterpret_cast<const bf16x8*>(Qw + d0 * 16);
    const int vbase = (int)(uintptr_t)(lds + B2_V) + v_rd_base(lane);
    int ka[4];
#pragma unroll
    for (int d = 0; d < 4; ++d) ka[d] = r32 * 256 + ((d * 32 + hi * 16) ^ ((r32 & 7) << 4));
    unsigned kof[2], vof[2];
#pragma unroll
    for (int i = 0; i < 2; ++i) { const int n = wid * 128 + i * 64 + lane;
        { const int row = n >> 4, ch = (n & 15) ^ (row & 7); kof[i] = (unsigned)(row * (LDK * 2) + ch * 16); }
        { const int st = n >> 5, wi = n & 31, kk = (st >> 2) * 8 + (wi >> 2), k = (kk & ~0xC) | ((kk & 4) << 1) | ((kk & 8) >> 1), c = (st & 3) * 32 + (wi & 3) * 8; vof[i] = (unsigned)(k * (LDV * 2) + c * 2); } }
    const unsigned ldsw = (unsigned)wid * 2048u;
#define GLDS(gp, lp) __builtin_amdgcn_global_load_lds((const unsigned*)(gp), (LAS unsigned*)(lp), 16, 0, 0)
#define DMA(j_, b_) do { const char* kt_ = (const char*)Kh + (size_t)(j_) * (KVBLK * LDK * 2); const char* vl_ = (const char*)Vlo + (size_t)(j_) * (KVBLK * LDV * 2); const char* vh_ = (const char*)Vhi + (size_t)(j_) * (KVBLK * LDV * 2); \
    _Pragma("unroll") for (int i_ = 0; i_ < 2; ++i_) { GLDS(kt_ + kof[i_], lds + B2_K + (b_) * 16384 + ldsw + i_ * 1024); \
        GLDS(vl_ + vof[i_], lds + B2_V + (b_) * 32768 + ldsw + i_ * 1024); GLDS(vh_ + vof[i_], lds + B2_V + (b_) * 32768 + 16384 + ldsw + i_ * 1024); } } while (0)
    f32x16 p0, p1; float mn, al; bf16x8 pa0, pa1, pa2, pa3;
#define PH_X(kb) do { qkt4(p0, p1, lds + B2_K + (kb) * 16384, qr, ka); partialSM(p0, p1, m_reg, mn, al); finishSM(p0, p1, al, l_reg, pa0, pa1, pa2, pa3); \
    if (__any(al < 1.f)) { if (hi == 0) al_l[r32] = al; asm volatile("s_waitcnt lgkmcnt(0)" ::: "memory"); \
        _Pragma("unroll") for (int d = 0; d < 8; ++d) _Pragma("unroll") for (int r = 0; r < 16; ++r) o[d][r] *= al_l[crow(r, hi)]; } } while (0)
#define PH_Y(vb) do { pv_pipe8(o, vbase + (vb) * 32768, pa0, pa1, pa2, pa3); } while (0)
    DMA(0, 0);
    asm volatile("s_waitcnt vmcnt(0)" ::: "memory"); __syncthreads();
#pragma nounroll
    for (int j = 0; j < NT; ++j) {
        if (j + 1 < NT) DMA(j + 1, (j + 1) & 1);
        PH_X(j & 1);
        PH_Y(j & 1);
        asm volatile("s_waitcnt vmcnt(0)" ::: "memory"); __syncthreads();
    }
    { int l2; asm volatile("v_mbcnt_lo_u32_b32 %0, -1, 0\n\tv_mbcnt_hi_u32_b32 %0, -1, %0" : "=v"(l2));
      const int r32e = l2 & 31, hie = l2 >> 5;
      if (hie == 0) li_l[r32e] = l_reg; asm volatile("s_waitcnt lgkmcnt(0)" ::: "memory");
      float rli[16];
#pragma unroll
      for (int r = 0; r < 16; ++r) rli[r] = __builtin_amdgcn_rcpf(li_l[crow(r, hie)]);
      if (EPI == 0) {
          bf16_t* Ow = Ob + (long)(wid * QBLK) * LDO;
#pragma unroll
          for (int r = 0; r < 16; ++r) { const int orow = crow(r, hie);
#pragma unroll
              for (int d0 = 0; d0 < 8; ++d0) Ow[(long)orow * LDO + d0 * 32 + r32e] = f2bf(o[d0][r] * rli[r]); }
      } else if (EPI == 1) {
          float* sc = Oscr + (wid * 64 + l2);
#pragma unroll
          for (int d0 = 0; d0 < 8; ++d0)
#pragma unroll
              for (int r = 0; r < 16; ++r) sc[(d0 * 16 + r) * 512] = o[d0][r] * rli[r];
      } else {
          const float lam_ = ((const LAS float*)(lds + B2_LAM))[0];
          const float* sc = Oscr + (wid * 64 + l2); float gs[8];
#pragma unroll
          for (int d0 = 0; d0 < 8; ++d0) gs[d0] = gsub[d0 * 32 + r32e] * post;
          bf16_t* Ow = Ob + (long)(wid * QBLK) * LDO;
#pragma unroll
          for (int rg = 0; rg < 4; ++rg) { float c4[4][8];
#pragma unroll
              for (int q = 0; q < 4; ++q)
#pragma unroll
                  for (int d0 = 0; d0 < 8; ++d0) c4[q][d0] = sc[(d0 * 16 + rg * 4 + q) * 512];
              asm volatile("" ::: "memory");
#pragma unroll
              for (int q = 0; q < 4; ++q) { const int r = rg * 4 + q; float ss = 0.f;
#pragma unroll
                  for (int d0 = 0; d0 < 8; ++d0) { c4[q][d0] -= lam_ * (o[d0][r] * rli[r]); ss += c4[q][d0] * c4[q][d0]; }
                  ss += __shfl_xor(ss, 1); ss += __shfl_xor(ss, 2); ss += __shfl_xor(ss, 4); ss += __shfl_xor(ss, 8); ss += __shfl_xor(ss, 16);
                  const float rs = rsqrtf(ss * (1.0f / 256.0f) + NORM_EPS); const int orow = crow(r, hie);
#pragma unroll
                  for (int d0 = 0; d0 < 8; ++d0) Ow[(long)orow * LDO + d0 * 32 + r32e] = f2bf(c4[q][d0] * rs * gs[d0]); } }
      } }
    asm volatile("s_waitcnt vmcnt(0)" ::: "memory");
    __syncthreads();
#undef GLDS
#undef DMA
#undef PH_X
#undef PH_Y
}
}

constexpr size_t al256(size_t x) { return (x + 255) / 256 * 256; }
constexpr size_t WS_CTL      = 0;
constexpr size_t CTL_BAR     = 0;
constexpr size_t CTL_CNT     = 16384;
constexpr size_t CTL_BYTES   = 32768;
constexpr size_t WS_W_LRU_IN = WS_CTL + CTL_BYTES;
constexpr size_t WS_W_LRU_G  = WS_W_LRU_IN + (size_t)4096 * 2048 * 2;
constexpr size_t WS_W_LRU_O  = WS_W_LRU_G + (size_t)8 * 1024 * 256 * 2;
constexpr size_t WS_W_DF_QKV = WS_W_LRU_O + (size_t)2048 * 2048 * 2;
constexpr size_t WS_W_DF_O   = WS_W_DF_QKV + (size_t)6144 * 2048 * 2;
constexpr size_t WS_W_WN_QKV = WS_W_DF_O + (size_t)2048 * 2048 * 2;
constexpr size_t WS_W_WN_O   = WS_W_WN_QKV + (size_t)3072 * 2048 * 2;
constexpr size_t WS_W_S5_IN  = WS_W_WN_O + (size_t)2048 * 2048 * 2;
constexpr size_t WS_W_S5_GLU = WS_W_S5_IN + (size_t)1024 * 2048 * 2;
constexpr size_t WS_W_S5_O   = WS_W_S5_GLU + (size_t)1024 * 1024 * 2;
constexpr size_t WS_S5_E     = WS_W_S5_O + (size_t)2048 * 1024 * 2;
constexpr size_t WS_S5_TF    = WS_S5_E + (size_t)64 * 256 * 256 * 2;
constexpr size_t WS_S5_LAM   = WS_S5_TF + (size_t)64 * 256 * 512 * 2;
constexpr size_t WS_ROPE     = WS_S5_LAM + (size_t)64 * 2 * 64 * 2 * 4;
constexpr size_t WS_SPT      = WS_ROPE + (size_t)S_ * 32 * 4;
constexpr size_t WS_WRT      = WS_SPT + (size_t)2 * 2048 * 4;
constexpr size_t WS_W_MOE    = WS_WRT + (size_t)4 * 36 * 2048 * 4;
constexpr size_t MOE_GU_B    = (size_t)1024 * 2048 * 2, MOE_DN_B = (size_t)2048 * 512 * 2, MOE_LE_B = MOE_GU_B + MOE_DN_B;
constexpr size_t WS_X        = WS_W_MOE + (size_t)128 * MOE_LE_B;
constexpr size_t WS_RS       = WS_X + (size_t)(S_ + 8) * 2048 * 2;
constexpr size_t WS_RSG      = WS_RS + (size_t)S_ * 4;
constexpr size_t WS_H        = WS_X + (size_t)S_ * 2048 * 4;
constexpr size_t WS_ROWTOK   = al256(WS_H + (size_t)(S_ + 1) * 2048 * 2);
constexpr size_t WS_TOPE     = WS_ROWTOK + (size_t)32 * 8192 * 4;
constexpr size_t WS_TOPW     = WS_TOPE + (size_t)S_ * 2 * 4;
constexpr size_t WS_SLOT     = WS_TOPW + (size_t)S_ * 2 * 4;
constexpr size_t WS_HDN      = WS_SLOT + (size_t)S_ * 2 * 4;
constexpr size_t WS_YS       = WS_HDN + (size_t)MAXTILES * 256 * 512 * 2;
constexpr size_t WS_ARENA    = WS_YS + (size_t)MAXTILES * 256 * 2048 * 2;
constexpr size_t AR_GATE = 0, AR_XRP = AR_GATE + (size_t)S_ * 2048 * 2, AR_XR = AR_XRP + (size_t)S_ * 2048 * 2, AR_YG = AR_XR + (size_t)S_ * 2048 * 2;
constexpr size_t AR_LAB = AR_YG + (size_t)S_ * 2048 * 2, AR_CHA = AR_LAB + (size_t)2 * S_ * 2048 * 4;
constexpr size_t AR_CHB = AR_CHA + (size_t)2 * NCH * 2048 * 4, AR_CAR = AR_CHB + (size_t)2 * NCH * 2048 * 4, AR_LRU_END = AR_CAR + (size_t)2 * NCH * 2048 * 4;
constexpr size_t AR_Q = 0, AR_K = AR_Q + (size_t)S_ * 2048 * 2, AR_V = AR_K + (size_t)S_ * 2048 * 2, AR_O = AR_V + (size_t)S_ * 2048 * 2, AR_OD = AR_O + (size_t)S_ * 4096 * 2;
constexpr size_t AR_ATT_END = AR_OD + (size_t)S_ * 2048 * 2;
constexpr size_t AR_U = 0, AR_UA = AR_U + (size_t)S_ * 1024 * 4, AR_SL = AR_UA + (size_t)64 * 512 * 512 * 2, AR_G = AR_SL + (size_t)64 * 512 * 256 * 4;
constexpr size_t AR_Z = AR_G + (size_t)S_ * 1024 * 2, AR_S5_END = AR_Z + (size_t)S_ * 1024 * 2;
constexpr size_t WS_END = WS_ARENA + (AR_LRU_END > AR_ATT_END ? (AR_LRU_END > AR_S5_END ? AR_LRU_END : AR_S5_END) : (AR_ATT_END > AR_S5_END ? AR_ATT_END : AR_S5_END));

constexpr int LDS_BYTES = 147456;
constexpr int LDS_MISC = 131072;
constexpr int LDS_TLE = LDS_MISC + 64;
constexpr int LDS_TLI = LDS_TLE + MAXTILES * 4;
constexpr int LDS_CNT = LDS_TLI + MAXTILES * 4;
constexpr int LDS_TB  = LDS_CNT + 32 * 4;
constexpr int LDS_NT  = LDS_TB + 36 * 4;

struct DenseW { const float* src; bf16_t* dst; int K, N; const float* gain; };
struct Args {
    const float* in[40];
    float* out; unsigned char* ws;
    DenseW dw[10];
    int ph_lo, ph_hi, grid, pad;
};

enum { I_X = 0, I_POS, I_LN_MIX, I_LN_FFN, I_LN_FINAL, I_LRU_W_IN, I_LRU_CONV_W, I_LRU_CONV_B, I_LRU_W_A, I_LRU_W_X, I_LRU_B_A, I_LRU_B_X, I_LRU_LAMBDA, I_LRU_W_OUT,
       I_DIFF_W_QKV, I_DIFF_LQ1, I_DIFF_LK1, I_DIFF_LQ2, I_DIFF_LK2, I_DIFF_SUBLN, I_DIFF_W_OUT, I_WIN_W_QKV, I_WIN_SINK, I_WIN_W_OUT,
       I_S5_W_IN, I_S5_A_RE, I_S5_A_IM, I_S5_LOG_DT, I_S5_B_RE, I_S5_B_IM, I_S5_C_RE, I_S5_C_IM, I_S5_D, I_S5_W_GLU, I_S5_W_OUT,
       I_MOE_W_GROUP, I_MOE_W_EXPERT, I_MOE_W_GATE, I_MOE_W_UP, I_MOE_W_DOWN, N_INPUTS };

typedef const Args __attribute__((address_space(4))) CArgs;
__device__ __forceinline__ CArgs* kargs() { CArgs* p = (CArgs*)__builtin_amdgcn_kernarg_segment_ptr(); asm volatile("" : "+s"(p)); return p; }
__device__ __forceinline__ int lane_id_opaque() { int l; asm volatile("v_mbcnt_lo_u32_b32 %0, -1, 0\n\tv_mbcnt_hi_u32_b32 %0, -1, %0" : "=v"(l)); return l; }
#define TID() (wave_s * 64 + lane_id_opaque())
#define GRID_N ((int)kargs()->grid)
#define BLOCK_ID ((int)__builtin_amdgcn_workgroup_id_x())

__device__ const double ROPE_INV[16] = {1.0, 0.44036660267178046, 0.19392274474868576, 0.08539710028576561, 0.03760603093086393, 0.016560440080994446, 0.007292664737217109, 0.003211445994752591, 0.001414213562373095, 0.000622772421914596, 0.0002742481756762073, 0.00012076973741146504, 5.318295896944988e-05, 2.341999896140934e-05, 1.031338537721246e-05, 4.5416704806078695e-06};

__device__ __forceinline__ void sincos_d(double x, float& sn, float& cs) {
    const double k = rint(x * 0.15915494309189535); const double r = x - k * 6.283185307179586, r2 = r * r;
    double s = r, ts = r, c = 1.0, tc = 1.0;
#pragma unroll
    for (int n = 1; n <= 13; ++n) { ts *= -r2 / (double)((2 * n) * (2 * n + 1)); s += ts; tc *= -r2 / (double)((2 * n - 1) * (2 * n)); c += tc; }
    sn = (float)s; cs = (float)c;
}

template <class F>
__device__ __forceinline__ void convT_load(float (&v)[16], const F& f, int n0, int k0, int tid) {
    const int nn = tid & 127, kq = tid >> 7; const float* cp = f.colptr(n0 + nn) + (size_t)(k0 + kq) * f.ld;
#pragma unroll
    for (int it = 0; it < 16; ++it) v[it] = __builtin_nontemporal_load(cp + (size_t)(4 * it) * f.ld);
}
__device__ __forceinline__ void convT_put(LAS float* tile, const float (&v)[16], int tid) {
    const int nn = tid & 127, kq = tid >> 7;
#pragma unroll
    for (int it = 0; it < 16; ++it) tile[nn * 65 + kq + 4 * it] = v[it];
}
__device__ __forceinline__ void convT_gain(const float* gain, int k0, int tid, f32x4& g0, f32x4& g1) {
    g0 = (f32x4){1.f, 1.f, 1.f, 1.f}; g1 = g0; if (gain) { g0 = *(const f32x4*)(gain + k0 + (tid & 7) * 8); g1 = *(const f32x4*)(gain + k0 + (tid & 7) * 8 + 4); }
}
__device__ __forceinline__ void convT_store(const LAS float* tile, bf16_t* dst, int K, int n0, int k0, int tid, const f32x4 g0, const f32x4 g1) {
#pragma unroll
    for (int r = 0; r < 2; ++r) { const int q = tid + 512 * r, nn = q >> 3, kc = q & 7; const LAS float* tp = tile + nn * 65 + kc * 8;
        u32x4 w; w.x = cvt_pk_bf16(tp[0] * g0[0], tp[1] * g0[1]); w.y = cvt_pk_bf16(tp[2] * g0[2], tp[3] * g0[3]); w.z = cvt_pk_bf16(tp[4] * g1[0], tp[5] * g1[1]); w.w = cvt_pk_bf16(tp[6] * g1[2], tp[7] * g1[3]);
        __builtin_nontemporal_store(w, (u32x4*)(dst + (size_t)(n0 + nn) * K + k0 + kc * 8)); }
}
struct ColPlain { const float* src; bf16_t* dst; int ld, K; const float* gain; __device__ __forceinline__ const float* colptr(int n) const { return src + n; } };
struct ColGU { const float* wg; long long du; bf16_t* dst; int ld, K; const float* gain;
    __device__ __forceinline__ const float* colptr(int c) const { const int j = (c >> 5) * 16 + (c & 15); return (const float*)((const char*)wg + ((c & 16) ? du : 0ll)) + j; } };


constexpr int MOE_L0_TILES = 32 * 384, MOE_ALL_TILES = 128 * 384;
constexpr size_t CTL_CURSOR = 24576;
constexpr size_t CTL_CURSOR0 = 24576 + 2048;
constexpr int LDS_GRAB = 131072 + 32;
constexpr int MOE_LAYER_TILES = 32 * 384, MOE_GU_TILES = 32 * 256;
__device__ __forceinline__ void moe_tile_decode(int t, int& le, int& r) {
    const int layer = t / MOE_LAYER_TILES, q = t % MOE_LAYER_TILES;
    if (q < MOE_GU_TILES) { le = layer * 32 + (q >> 8); r = q & 255; } else { const int q2 = q - MOE_GU_TILES; le = layer * 32 + (q2 >> 7); r = 256 + (q2 & 127); }
}
__device__ __forceinline__ void moe_tile_load(CArgs* ap, float (&v)[16], f32x4& g0, f32x4& g1, int t, int tid) {
    const float* wgate = ap->in[I_MOE_W_GATE]; const float* wup = ap->in[I_MOE_W_UP]; const float* wdn = ap->in[I_MOE_W_DOWN];
    int le, r; moe_tile_decode(t, le, r);
    if (r < 256) { ColGU f{wgate + (size_t)le * 2048 * 512, (long long)((const char*)wup - (const char*)wgate), nullptr, 512, 2048, nullptr}; convT_load(v, f, (r / 32) * 128, (r % 32) * 64, tid); convT_gain(ap->in[I_LN_FFN] + (le >> 5) * 2048, (r % 32) * 64, tid, g0, g1); }
    else { const int q = r - 256; ColPlain f{wdn + (size_t)le * 512 * 2048, nullptr, 2048, 512, nullptr}; convT_load(v, f, (q / 8) * 128, (q % 8) * 64, tid); convT_gain(nullptr, 0, tid, g0, g1); }
}
__device__ __forceinline__ void moe_tile_store(CArgs* ap, const LAS float* tile, int t, int tid, const f32x4 g0, const f32x4 g1) {
    int le, r; moe_tile_decode(t, le, r); bf16_t* base = (bf16_t*)(ap->ws + WS_W_MOE + (size_t)le * MOE_LE_B);
    if (r < 256) convT_store(tile, base, 2048, (r / 32) * 128, (r % 32) * 64, tid, g0, g1);
    else { const int q = r - 256; convT_store(tile, base + (size_t)1024 * 2048, 512, (q / 8) * 128, (q % 8) * 64, tid, g0, g1); }
}
constexpr int ND_TILES = 5504;
constexpr int LDS_DW = LDS_NT + 16;
__device__ __forceinline__ void dense_desc_build(CArgs* ap, LAS unsigned char* lds, int tid) {
    LAS int* d = (LAS int*)(lds + LDS_DW);
    if (tid == 0) { int acc = 0;
#pragma unroll
        for (int mi = 0; mi < 9; ++mi) { const unsigned long long sp = (unsigned long long)ap->dw[mi].src, dp = (unsigned long long)ap->dw[mi].dst, gp = (unsigned long long)ap->dw[mi].gain; const int K = ap->dw[mi].K, N = ap->dw[mi].N;
            d[mi * 12 + 0] = (int)(unsigned)sp; d[mi * 12 + 1] = (int)(unsigned)(sp >> 32); d[mi * 12 + 2] = (int)(unsigned)dp; d[mi * 12 + 3] = (int)(unsigned)(dp >> 32);
            d[mi * 12 + 4] = K; d[mi * 12 + 5] = N; d[mi * 12 + 6] = acc; d[mi * 12 + 7] = K / 64; d[mi * 12 + 8] = (int)(unsigned)gp; d[mi * 12 + 9] = (int)(unsigned)(gp >> 32); acc += (K / 64) * (N / 128); } }
    __syncthreads();
}
struct DenseTile { const float* src; bf16_t* dst; const float* gain; int K, N, n0, k0; };
__device__ __forceinline__ DenseTile dense_lookup(LAS unsigned char* lds, int u) {
    const LAS int* d = (const LAS int*)(lds + LDS_DW); int mi = 0;
#pragma unroll
    for (int i = 1; i < 9; ++i) if (u >= d[i * 12 + 6]) mi = i;
    mi = __builtin_amdgcn_readfirstlane(mi); const LAS int* e = d + mi * 12; DenseTile t;
    t.gain = (const float*)(((unsigned long long)(unsigned)e[9] << 32) | (unsigned)e[8]);
    t.src = (const float*)(((unsigned long long)(unsigned)e[1] << 32) | (unsigned)e[0]); t.dst = (bf16_t*)(((unsigned long long)(unsigned)e[3] << 32) | (unsigned)e[2]);
    t.K = e[4]; t.N = e[5]; const int tl = u - e[6], tk = e[7]; t.n0 = (tl / tk) * 128; t.k0 = (tl % tk) * 64; return t;
}
__device__ __forceinline__ void any_tile_load(CArgs* ap, LAS unsigned char* lds, float (&v)[16], f32x4& g0, f32x4& g1, int u, int tid) {
    if (u < ND_TILES) { const DenseTile t = dense_lookup(lds, u); ColPlain f{t.src, nullptr, t.N, t.K, nullptr}; convT_load(v, f, t.n0, t.k0, tid); convT_gain(t.gain, t.k0, tid, g0, g1); }
    else moe_tile_load(ap, v, g0, g1, u - ND_TILES, tid);
}
__device__ __forceinline__ void any_tile_store(CArgs* ap, LAS unsigned char* lds, const LAS float* tile, int u, int tid, const f32x4 g0, const f32x4 g1) {
    if (u < ND_TILES) { const DenseTile t = dense_lookup(lds, u); convT_store(tile, t.dst, t.K, t.n0, t.k0, tid, g0, g1); }
    else moe_tile_store(ap, tile, u - ND_TILES, tid, g0, g1);
}
template <bool PEEK>
__device__ __forceinline__ void conv_stream(CArgs* ap, LAS unsigned char* lds, size_t cursor_off, int lo, int hi, int max_chunks, int end_id, int tid) {
    LAS float* tile0 = (LAS float*)lds; LAS float* tile1 = tile0 + 128 * 65; LAS int* g = (LAS int*)(lds + LDS_GRAB);
    int base = 0, k = 4, chunks = 0; bool open = true;
#define CS_NEXT(dst) do { dst = -1; \
        if (k == 4 && open && chunks < max_chunks) { \
            if (tid == 0) { unsigned* cur = (unsigned*)(ap->ws + cursor_off); int got = -1; \
                if (!PEEK || lo + (int)__hip_atomic_load(cur, __ATOMIC_RELAXED, __HIP_MEMORY_SCOPE_AGENT) < end_id) got = (int)__hip_atomic_fetch_add(cur, 4u, __ATOMIC_RELAXED, __HIP_MEMORY_SCOPE_AGENT); \
                g[0] = got; } \
            __syncthreads(); const int got_ = g[0]; __syncthreads(); ++chunks; \
            if (got_ < 0 || lo + got_ >= hi) open = false; else { base = lo + got_; k = 0; if (base >= end_id) open = false; } } \
        if (k < 4) { dst = base + k; ++k; } } while (0)
    float vA[16], vB[16]; f32x4 gA0, gA1, gB0, gB1; int tA, tB;
    gA0 = gA1 = gB0 = gB1 = (f32x4){1.f, 1.f, 1.f, 1.f};
    CS_NEXT(tA); if (tA < 0) return; any_tile_load(ap, lds, vA, gA0, gA1, tA, tid);
    CS_NEXT(tB); if (tB >= 0) any_tile_load(ap, lds, vB, gB0, gB1, tB, tid);
    for (;;) {
        convT_put(tile0, vA, tid); __syncthreads();
        const int sA = tA; const f32x4 hA0 = gA0, hA1 = gA1; tA = -1; if (tB >= 0) { CS_NEXT(tA); } if (tA >= 0) any_tile_load(ap, lds, vA, gA0, gA1, tA, tid);
        any_tile_store(ap, lds, tile0, sA, tid, hA0, hA1);
        if (tB < 0) break;
        convT_put(tile1, vB, tid); __syncthreads();
        const int sB = tB; const f32x4 hB0 = gB0, hB1 = gB1; tB = -1; if (tA >= 0) { CS_NEXT(tB); } if (tB >= 0) any_tile_load(ap, lds, vB, gB0, gB1, tB, tid);
        any_tile_store(ap, lds, tile1, sB, tid, hB0, hB1);
        if (tA < 0) break;
    }
#undef CS_NEXT
    __syncthreads();
}
constexpr int CONV_NOLIMIT = 0x3fffffff;
__device__ __forceinline__ void tail_convert(CArgs* ap, LAS unsigned char* lds, int quota, int tid) {
    if (quota <= 0) return; conv_stream<false>(ap, lds, CTL_CURSOR, ND_TILES + MOE_GU_TILES, ND_TILES + MOE_ALL_TILES, (quota + 3) / 4, CONV_NOLIMIT, tid);
}
__device__ __forceinline__ void catchup_convert(CArgs* ap, LAS unsigned char* lds, int end_tile, int tid) {
    conv_stream<true>(ap, lds, CTL_CURSOR, ND_TILES + MOE_GU_TILES, ND_TILES + MOE_ALL_TILES, CONV_NOLIMIT, ND_TILES + end_tile, tid);
}
__device__ __forceinline__ void prologue_weights(const Args __attribute__((address_space(4)))* ap, LAS unsigned char* lds, int tid) {
    LAS float* tile = (LAS float*)lds;
    const int G = GRID_N, bid = BLOCK_ID;
    dense_desc_build(ap, lds, tid);
    conv_stream<false>(ap, lds, CTL_CURSOR0, 0, ND_TILES + MOE_GU_TILES, CONV_NOLIMIT, CONV_NOLIMIT, tid);
    { const float* wa = ap->in[I_LRU_W_A]; const float* wx = ap->in[I_LRU_W_X]; bf16_t* dst = (bf16_t*)(ap->ws + WS_W_LRU_G);
      for (int it = bid * NTHREADS + tid; it < 8 * 1024 * 32; it += G * NTHREADS) {
          const int kk0 = (it & 31) * 8, c = (it >> 5) & 1023, p = it >> 15;
          const int dir = c >> 9, cp = c & 511, q = cp >> 5, gate = (cp >> 4) & 1, chl = 16 * q + (cp & 15), hb = 2 * p + (chl >> 7), j = chl & 127;
          float v[8];
          if ((kk0 >> 7) == (chl >> 7)) { const float* s = (gate ? wx : wa) + (((size_t)dir * 16 + hb) * 128 + (kk0 & 127)) * 128 + j;
#pragma unroll
              for (int e = 0; e < 8; ++e) v[e] = s[(size_t)e * 128]; }
          else {
#pragma unroll
              for (int e = 0; e < 8; ++e) v[e] = 0.f; }
          u32x4 w; w.x = cvt_pk_bf16(v[0], v[1]); w.y = cvt_pk_bf16(v[2], v[3]); w.z = cvt_pk_bf16(v[4], v[5]); w.w = cvt_pk_bf16(v[6], v[7]);
          *(u32x4*)(dst + ((size_t)p * 1024 + c) * 256 + kk0) = w; } }
    { const int* pos = (const int*)ap->in[I_POS]; float* cs = (float*)(ap->ws + WS_ROPE);
      for (int it = bid * NTHREADS + tid; it < S_ * 16; it += G * NTHREADS) { const int t = it >> 4, i = it & 15;
          float sn, cn; sincos_d((double)pos[t] * ROPE_INV[i], sn, cn);
          cs[t * 32 + i] = cn; cs[t * 32 + 16 + i] = sn; } }
    { const float* lam = ap->in[I_LRU_LAMBDA]; float* spt = (float*)(ap->ws + WS_SPT); for (int it = bid * NTHREADS + tid; it < 2 * 2048; it += G * NTHREADS) spt[it] = log1pf(expf(-lam[it])); }
    { const float* wg = ap->in[I_MOE_W_GROUP]; const float* we = ap->in[I_MOE_W_EXPERT]; const float* gf = ap->in[I_LN_FFN]; float* wrt = (float*)(ap->ws + WS_WRT);
      for (int it = bid * NTHREADS + tid; it < 4 * 36 * 2048; it += G * NTHREADS) { const int k = it & 2047, j = (it >> 11) % 36, l = it / (36 * 2048);
          const float w = (j < 4) ? wg[((size_t)l * 2048 + k) * 4 + j] : we[((size_t)l * 2048 + k) * 32 + (j - 4)]; wrt[it] = w * gf[l * 2048 + k]; } }
    { bf16_t* X = (bf16_t*)(ap->ws + WS_X); if (bid == 0) for (int i = tid; i < 2048; i += NTHREADS) X[(size_t)S_ * 2048 + i] = 0; }
}

__device__ __forceinline__ void s5_tables(const Args __attribute__((address_space(4)))* ap, LAS unsigned char* lds, int g, int tid) {
    LAS float* LP = (LAS float*)lds;
    LAS float* BB = LP + 2 * 64 * 17 * 2;
    LAS float* CC = BB + 2 * 64 * 16 * 2;
    LAS float* KT = CC + 2 * 16 * 64 * 2;
    const float* a_re = ap->in[I_S5_A_RE]; const float* a_im = ap->in[I_S5_A_IM]; const float* log_dt = ap->in[I_S5_LOG_DT];
    const float* b_re = ap->in[I_S5_B_RE]; const float* b_im = ap->in[I_S5_B_IM]; const float* c_re = ap->in[I_S5_C_RE]; const float* c_im = ap->in[I_S5_C_IM];
    if (tid < 128) { const int dir = tid >> 6, n = tid & 63; const size_t sn = ((size_t)dir * 64 + g) * 64 + n;
        const float ar = a_re[sn], ai = a_im[sn]; const float dt = expf(log_dt[dir * 64 + g]);
        const float mag = expf(dt * ar); float sv, cv; sincos_d((double)dt * (double)ai, sv, cv); const float lr = mag * cv, li = mag * sv;
        const float den = ar * ar + ai * ai, nr = lr - 1.0f, ni = li; const float fr = (nr * ar + ni * ai) / den, fi = (ni * ar - nr * ai) / den;
        float pr = 1.f, pi = 0.f;
        for (int j = 0; j <= 16; ++j) { LP[((dir * 64 + n) * 17 + j) * 2] = pr; LP[((dir * 64 + n) * 17 + j) * 2 + 1] = pi; const float t = pr * lr - pi * li; pi = pr * li + pi * lr; pr = t; }
        float* lam16 = (float*)(ap->ws + WS_S5_LAM) + (((size_t)g * 2 + dir) * 64 + n) * 2;
        lam16[0] = LP[((dir * 64 + n) * 17 + 16) * 2]; lam16[1] = LP[((dir * 64 + n) * 17 + 16) * 2 + 1];
        for (int ci = 0; ci < 16; ++ci) { const float br = b_re[sn * 16 + ci], bi = b_im[sn * 16 + ci];
            BB[((dir * 64 + n) * 16 + ci) * 2] = fr * br - fi * bi; BB[((dir * 64 + n) * 16 + ci) * 2 + 1] = fr * bi + fi * br; } }
    for (int it = tid; it < 2 * 16 * 64; it += NTHREADS) { const int dir = it >> 10, co = (it >> 6) & 15, n = it & 63; const size_t s = (((size_t)dir * 64 + g) * 16 + co) * 64 + n;
        CC[it * 2] = c_re[s]; CC[it * 2 + 1] = c_im[s]; }
    __syncthreads();
    for (int it = tid; it < 2 * 16 * 256; it += NTHREADS) { const int dir = it >> 12, j = (it >> 8) & 15, co = (it >> 4) & 15, ci = it & 15; float s = 0.f;
        for (int n = 0; n < 64; ++n) { const float pr = LP[((dir * 64 + n) * 17 + j) * 2], pi = LP[((dir * 64 + n) * 17 + j) * 2 + 1];
            const float br = BB[((dir * 64 + n) * 16 + ci) * 2], bi = BB[((dir * 64 + n) * 16 + ci) * 2 + 1];
            const float qr = pr * br - pi * bi, qi = pr * bi + pi * br;
            const float cr = CC[((dir * 16 + co) * 64 + n) * 2], ci_ = CC[((dir * 16 + co) * 64 + n) * 2 + 1];
            s += cr * qr - ci_ * qi; }
        KT[it] = s; }
    { bf16_t* Et = (bf16_t*)(ap->ws + WS_S5_E) + (size_t)g * 256 * 256;
      for (int it = tid; it < 256 * 128; it += NTHREADS) { const int nidx = it >> 7, k = (it & 127) * 2; const int dir = nidx >> 7, n = (nidx & 127) >> 1, ri = nidx & 1;
          float v[2];
#pragma unroll
          for (int e = 0; e < 2; ++e) { const int l = (k + e) >> 4, ci = (k + e) & 15, pw = dir ? l : 15 - l;
              const float pr = LP[((dir * 64 + n) * 17 + pw) * 2], pi = LP[((dir * 64 + n) * 17 + pw) * 2 + 1];
              const float br = BB[((dir * 64 + n) * 16 + ci) * 2], bi = BB[((dir * 64 + n) * 16 + ci) * 2 + 1];
              v[e] = ri ? (pr * bi + pi * br) : (pr * br - pi * bi); }
          *(unsigned*)(Et + (size_t)nidx * 256 + k) = cvt_pk_bf16(v[0], v[1]); } }
    __syncthreads();
    { bf16_t* TF = (bf16_t*)(ap->ws + WS_S5_TF) + (size_t)g * 256 * 512;
      for (int it = tid; it < 256 * 256; it += NTHREADS) { const int nn = it >> 8, k = (it & 255) * 2; const int lt = nn >> 4, co = nn & 15;
          float v[2];
#pragma unroll
          for (int e = 0; e < 2; ++e) { const int kk = k + e;
              if (kk < 256) { const int ls = kk >> 4, ci = kk & 15; float s = 0.f;
                  if (lt >= ls) s += KT[((0 * 16 + (lt - ls)) * 16 + co) * 16 + ci];
                  if (ls >= lt) s += KT[((1 * 16 + (ls - lt)) * 16 + co) * 16 + ci];
                  v[e] = s; }
              else { const int nidx = kk - 256, dir = nidx >> 7, n = (nidx & 127) >> 1, ri = nidx & 1, pw = dir ? 16 - lt : lt + 1;
                  const float pr = LP[((dir * 64 + n) * 17 + pw) * 2], pi = LP[((dir * 64 + n) * 17 + pw) * 2 + 1];
                  const float cr = CC[((dir * 16 + co) * 64 + n) * 2], ci_ = CC[((dir * 16 + co) * 64 + n) * 2 + 1];
                  const float qr = cr * pr - ci_ * pi, qi = cr * pi + ci_ * pr;
                  v[e] = ri ? -qi : qr; } }
          *(unsigned*)(TF + (size_t)nn * 512 + k) = cvt_pk_bf16(v[0], v[1]); } }
    __syncthreads();
}

__device__ __forceinline__ void moe_table(const unsigned* cnt, LAS unsigned char* lds, int tid) {
    LAS int* tle = (LAS int*)(lds + LDS_TLE); LAS int* tli = (LAS int*)(lds + LDS_TLI); LAS int* lc = (LAS int*)(lds + LDS_CNT); LAS int* tb = (LAS int*)(lds + LDS_TB); LAS int* nt = (LAS int*)(lds + LDS_NT);
    if (tid < 64) { const int e = tid & 31; const int c = (int)cnt[e * 16]; const int tiles = (c + 255) >> 8; int incl = tiles;
#pragma unroll
        for (int d = 1; d < 32; d <<= 1) { const int v = __shfl_up(incl, d, 32); if (e >= d) incl += v; }
        const int start = incl - tiles;
        if (tid < 32) { lc[e] = c; tb[e] = start;
            for (int i = 0; i < tiles; ++i) if (start + i < MAXTILES) { tle[start + i] = e; tli[start + i] = i; }
            if (e == 31) nt[0] = incl < MAXTILES ? incl : MAXTILES; } }
    __syncthreads();
}
template <int MODE, bool FINAL, bool SRCBF>
__device__ __forceinline__ void norm_phase(const void* src, bf16_t* dstX, const float* gvec, bf16_t* H, float* RS, float* OUT,
                                           const bf16_t* ys, const int* tope, const float* topw, const int* slot, const unsigned* cnt, LAS unsigned char* lds, int tid) {
    const int lane = tid & 63, wid = tid >> 6; const int nw = GRID_N * 8;
    LAS int* tb = (LAS int*)(lds + LDS_TB);
    if (MODE == 1 && MK_SPLIT) moe_table(cnt, lds, tid);
    f32x4 gv[8];
#pragma unroll
    for (int i = 0; i < 8; ++i) gv[i] = *(const f32x4*)(gvec + i * 256 + lane * 4);
    for (int rowA = BLOCK_ID * 8 + wid; rowA < S_; rowA += 2 * nw) {
        const int rowB = rowA + nw; const bool hasB = rowB < S_; const int rB = hasB ? rowB : rowA;
        int e0[2] = {0, 0}, e1[2] = {0, 0}, s0[2] = {0, 0}, s1[2] = {0, 0}; float w0[2] = {0.f, 0.f}, w1[2] = {0.f, 0.f};
        if (MODE == 1) {
#pragma unroll
            for (int r = 0; r < 2; ++r) { const int row = r ? rB : rowA; e0[r] = tope[row * 2]; e1[r] = tope[row * 2 + 1]; w0[r] = topw[row * 2]; w1[r] = topw[row * 2 + 1]; s0[r] = slot[row * 2]; s1[r] = slot[row * 2 + 1]; } }
        f32x4 v[2][8]; u32x2 xb[2][8];
#pragma unroll
        for (int r = 0; r < 2; ++r) { const int row = r ? rB : rowA;
            if (SRCBF) { const bf16_t* xr = (const bf16_t*)src + (size_t)row * 2048;
#pragma unroll
                for (int i = 0; i < 8; ++i) xb[r][i] = *(const u32x2*)(xr + i * 256 + lane * 4); }
            else { const float* xr = (const float*)src + (size_t)row * 2048;
#pragma unroll
                for (int i = 0; i < 8; ++i) v[r][i] = *(const f32x4*)(xr + i * 256 + lane * 4); } }
        u32x2 a0[2][8], a1[2][8];
        if (MODE == 1) {
#pragma unroll
            for (int r = 0; r < 2; ++r) { const bf16_t* y0 = ys + ((size_t)tb[e0[r]] * 256 + s0[r]) * 2048; const bf16_t* y1 = ys + ((size_t)tb[e1[r]] * 256 + s1[r]) * 2048;
#pragma unroll
                for (int i = 0; i < 8; ++i) { a0[r][i] = *(const u32x2*)(y0 + i * 256 + lane * 4); a1[r][i] = *(const u32x2*)(y1 + i * 256 + lane * 4); } } }
        asm volatile("" ::: "memory");
#pragma unroll
        for (int r = 0; r < 2; ++r) { const int row = r ? rowB : rowA; if (r == 1 && !hasB) break;
            if (SRCBF) {
#pragma unroll
                for (int i = 0; i < 8; ++i) v[r][i] = (f32x4){bflo(xb[r][i].x), bfhi(xb[r][i].x), bflo(xb[r][i].y), bfhi(xb[r][i].y)}; }
            if (MODE == 1) {
#pragma unroll
                for (int i = 0; i < 8; ++i) {
                    v[r][i][0] += w0[r] * bflo(a0[r][i].x) + w1[r] * bflo(a1[r][i].x); v[r][i][1] += w0[r] * bfhi(a0[r][i].x) + w1[r] * bfhi(a1[r][i].x);
                    v[r][i][2] += w0[r] * bflo(a0[r][i].y) + w1[r] * bflo(a1[r][i].y); v[r][i][3] += w0[r] * bfhi(a0[r][i].y) + w1[r] * bfhi(a1[r][i].y); } }
            if (dstX) {
#pragma unroll
                for (int i = 0; i < 8; ++i) { u32x2 w; w.x = cvt_pk_bf16(v[r][i][0], v[r][i][1]); w.y = cvt_pk_bf16(v[r][i][2], v[r][i][3]); *(u32x2*)(dstX + (size_t)row * 2048 + i * 256 + lane * 4) = w; } }
            float ss = 0.f;
#pragma unroll
            for (int i = 0; i < 8; ++i) ss += v[r][i][0] * v[r][i][0] + v[r][i][1] * v[r][i][1] + v[r][i][2] * v[r][i][2] + v[r][i][3] * v[r][i][3];
            ss = wave_sum(ss); const float rstd = rsqrtf(ss * (1.0f / 2048.0f) + NORM_EPS);
            if (FINAL) {
#pragma unroll
                for (int i = 0; i < 8; ++i) { const f32x4 y = v[r][i] * rstd * gv[i]; __builtin_nontemporal_store(y, (f32x4*)(OUT + (size_t)row * 2048 + i * 256 + lane * 4)); } }
            else {
                if (lane == 0) RS[row] = rstd;
                if (!SRCBF) {
#pragma unroll
                    for (int i = 0; i < 8; ++i) { u32x2 w; w.x = cvt_pk_bf16(v[r][i][0], v[r][i][1]); w.y = cvt_pk_bf16(v[r][i][2], v[r][i][3]); *(u32x2*)(H + (size_t)row * 2048 + i * 256 + lane * 4) = w; } } } }
    }
}

__device__ __forceinline__ void router_phase(const bf16_t* __restrict__ X, float* __restrict__ rsg, const float* __restrict__ WRT,
                                             int* __restrict__ tope, float* __restrict__ topw, int* __restrict__ slot, int* __restrict__ rowtok, unsigned* cnt, LAS unsigned char* lds, int tid) {
    LAS float* part = (LAS float*)lds;
    LAS float* ssp = part + 8 * 32 * 36;
    LAS float* lg = ssp + 8 * 64;
    LAS float* rs = lg + 32 * 36;
    LAS float* w1s = (LAS float*)(lds + 45056);
    LAS float* gp = w1s + 4 * 2048;
    const int lane = tid & 63, wid = tid >> 6, i = lane & 31, h = lane >> 5;
    const int gstep32 = GRID_N * 32;
#pragma unroll
    for (int q = 0; q < 4; ++q) *(LAS f32x4*)(w1s + (q * 512 + tid) * 4) = *(const f32x4*)(WRT + (size_t)32 * 2048 + (q * 512 + tid) * 4);
    __syncthreads();
    for (int base = BLOCK_ID * 32; base < S_; base += gstep32) {
        { const bf16_t* xp = X + (size_t)(base + i) * 2048 + wid * 256 + 4 * h; const float* w0p = WRT + (size_t)i * 2048 + wid * 256 + 4 * h; const LAS float* w1l = w1s + wid * 256 + 4 * h;
          f32x16 acc0 = {}; f32x4 gacc = (f32x4){0.f, 0.f, 0.f, 0.f}; float ss = 0.f;
#pragma unroll
          for (int g = 0; g < 8; ++g) { u32x2 xq[4]; f32x4 b0q[4];
#pragma unroll
              for (int j = 0; j < 4; ++j) { const int m = g * 4 + j; xq[j] = *(const u32x2*)(xp + 8 * m); b0q[j] = *(const f32x4*)(w0p + 8 * m); }
              asm volatile("" ::: "memory");
#pragma unroll
              for (int j = 0; j < 4; ++j) asm volatile("" : "+v"(xq[j]), "+v"(b0q[j]));
#pragma unroll
              for (int j = 0; j < 4; ++j) { const int m = g * 4 + j;
                  const u32x2 xw_ = xq[j]; const f32x4 xa = (f32x4){bflo(xw_.x), bfhi(xw_.x), bflo(xw_.y), bfhi(xw_.y)}; const f32x4 b0 = b0q[j];
                  ss += xa[0] * xa[0] + xa[1] * xa[1] + xa[2] * xa[2] + xa[3] * xa[3];
#pragma unroll
                  for (int e = 0; e < 4; ++e) acc0 = __builtin_amdgcn_mfma_f32_32x32x2f32(xa[e], b0[e], acc0, 0, 0, 0);
#pragma unroll
                  for (int c = 0; c < 4; ++c) { const f32x4 wv = *(const LAS f32x4*)(w1l + c * 2048 + 8 * m); gacc[c] += xa[0] * wv[0] + xa[1] * wv[1] + xa[2] * wv[2] + xa[3] * wv[3]; }
                  asm volatile("" : "+v"(gacc) :: "memory"); }
              asm volatile("" ::: "memory"); }
#pragma unroll
          for (int r = 0; r < 16; ++r) { const int row = (r & 3) + 8 * (r >> 2) + 4 * h; part[(wid * 32 + row) * 36 + i] = acc0[r]; }
          *(LAS f32x4*)(gp + ((wid * 2 + h) * 32 + i) * 4) = gacc;
          ssp[(wid * 2 + h) * 32 + i] = ss; }
        __syncthreads();
        if (tid < 32) { float s = 0.f;
#pragma unroll
            for (int q = 0; q < 16; ++q) s += ssp[q * 32 + tid];
            rs[tid] = rsqrtf(s * (1.0f / 2048.0f) + NORM_EPS); }
        __syncthreads();
        for (int it = tid; it < 32 * 36; it += NTHREADS) { const int t = it / 36, j = it % 36; float s = 0.f;
            if (j < 32) {
#pragma unroll
                for (int w = 0; w < 8; ++w) s += part[(w * 32 + t) * 36 + j]; }
            else {
#pragma unroll
                for (int q = 0; q < 16; ++q) s += gp[(q * 32 + t) * 4 + (j - 32)]; }
            lg[it] = s * rs[t]; }
        __syncthreads();
        if (tid < 32) { const int t = tid, row = base + t; const LAS float* L = lg + t * 36;
            int gi = 0; float gm = L[0];
#pragma unroll
            for (int q = 1; q < 4; ++q) if (L[q] > gm) { gm = L[q]; gi = q; }
            float gs = 0.f;
#pragma unroll
            for (int q = 0; q < 4; ++q) gs += __expf(L[q] - gm);
            const float gp = 1.0f / gs;
            float el[8]; int i1 = 0; float m1 = -3.4e38f;
#pragma unroll
            for (int q = 0; q < 8; ++q) { el[q] = L[4 + gi * 8 + q]; if (el[q] > m1) { m1 = el[q]; i1 = q; } }
            int i2 = 0; float m2 = -3.4e38f;
#pragma unroll
            for (int q = 0; q < 8; ++q) if (q != i1 && el[q] > m2) { m2 = el[q]; i2 = q; }
            const float p2 = __expf(m2 - m1); const float w1 = gp / (1.0f + p2), w2 = gp * p2 / (1.0f + p2);
            const int e1 = gi * 8 + i1, e2 = gi * 8 + i2;
            const int s1 = (int)atomicAdd(&cnt[e1 * 16], 1u), s2 = (int)atomicAdd(&cnt[e2 * 16], 1u);
            rowtok[e1 * 8192 + s1] = row; rowtok[e2 * 8192 + s2] = row; { const float rv = rs[t]; rsg[e1 * 8192 + s1] = rv; rsg[e2 * 8192 + s2] = rv; }
            tope[row * 2] = e1; tope[row * 2 + 1] = e2; topw[row * 2] = w1; topw[row * 2 + 1] = w2; slot[row * 2] = s1; slot[row * 2 + 1] = s2; }
        __syncthreads();
    }
}

__device__ __forceinline__ void lru_conv_phase(const bf16_t* __restrict__ xrp, const float* __restrict__ cw, const float* __restrict__ cb, bf16_t* __restrict__ xr, int tid) {
    const int gstepT = GRID_N * NTHREADS;
    for (int it = BLOCK_ID * NTHREADS + tid; it < (S_ / 16) * 256; it += gstepT) {
        const int t0 = (it >> 8) * 16, c = (it & 255) * 8;
        u32x4 xin[19];
#pragma unroll
        for (int r = 0; r < 19; ++r) { const int ts = t0 + r - 2; xin[r] = (ts >= 0 && ts < S_) ? *(const u32x4*)(xrp + (size_t)ts * 2048 + c) : (u32x4){0u, 0u, 0u, 0u}; }
        f32x4 w0[4], w1[4];
#pragma unroll
        for (int k = 0; k < 4; ++k) { w0[k] = *(const f32x4*)(cw + k * 2048 + c); w1[k] = *(const f32x4*)(cw + k * 2048 + c + 4); }
        const f32x4 b0 = *(const f32x4*)(cb + c), b1 = *(const f32x4*)(cb + c + 4);
        asm volatile("" ::: "memory");
#pragma unroll
        for (int o = 0; o < 16; ++o) { f32x4 a0 = b0, a1 = b1;
#pragma unroll
            for (int k = 0; k < 4; ++k) { const u32x4 xw = xin[o + k];
                a0[0] += w0[k][0] * bflo(xw.x); a0[1] += w0[k][1] * bfhi(xw.x); a0[2] += w0[k][2] * bflo(xw.y); a0[3] += w0[k][3] * bfhi(xw.y);
                a1[0] += w1[k][0] * bflo(xw.z); a1[1] += w1[k][1] * bfhi(xw.z); a1[2] += w1[k][2] * bflo(xw.w); a1[3] += w1[k][3] * bfhi(xw.w); }
            u32x4 w; w.x = cvt_pk_bf16(a0[0], a0[1]); w.y = cvt_pk_bf16(a0[2], a0[3]); w.z = cvt_pk_bf16(a1[0], a1[1]); w.w = cvt_pk_bf16(a1[2], a1[3]);
            *(u32x4*)(xr + (size_t)(t0 + o) * 2048 + c) = w; }
    }
}
__device__ __forceinline__ void lru_scan1(const unsigned* __restrict__ LAB, float* __restrict__ CHA, float* __restrict__ CHB, int tid) {
    const int gstepT = GRID_N * NTHREADS;
    for (int it = BLOCK_ID * NTHREADS + tid; it < 2 * NCH * 512; it += gstepT) {
        const int c4 = (it & 511) * 4, ch = (it >> 9) & (NCH - 1), dir = it >> 16;
        f32x4 h = (f32x4){0.f, 0.f, 0.f, 0.f}, LS = (f32x4){0.f, 0.f, 0.f, 0.f};
        const unsigned* base = LAB + ((size_t)dir * S_ + (size_t)ch * CHL) * 2048 + c4;
        u32x4 wa[16], wb[16];
#pragma unroll
        for (int s = 0; s < 16; ++s) { const int tt = dir ? (CHL - 1 - s) : s; wa[s] = *(const u32x4*)(base + (size_t)tt * 2048); }
#pragma unroll
        for (int gq = 0; gq < CHL / 16; ++gq) {
            if (gq + 1 < CHL / 16) {
#pragma unroll
                for (int s = 0; s < 16; ++s) { const int s2 = (gq + 1) * 16 + s; const int tt = dir ? (CHL - 1 - s2) : s2; wb[s] = *(const u32x4*)(base + (size_t)tt * 2048); } }
            asm volatile("" ::: "memory");
#pragma unroll
            for (int s = 0; s < 16; ++s) { const u32x4 w = wa[s];
#pragma unroll
                for (int j = 0; j < 4; ++j) { const float la = bflo(w[j]); h[j] = __expf(la) * h[j] + bfhi(w[j]); LS[j] += la; } }
#pragma unroll
            for (int s = 0; s < 16; ++s) wa[s] = wb[s];
        }
        f32x4 P; P[0] = __expf(LS[0]); P[1] = __expf(LS[1]); P[2] = __expf(LS[2]); P[3] = __expf(LS[3]);
        *(f32x4*)(CHA + ((size_t)dir * NCH + ch) * 2048 + c4) = P; *(f32x4*)(CHB + ((size_t)dir * NCH + ch) * 2048 + c4) = h; }
}
__device__ __forceinline__ void lru_scan3(const unsigned* __restrict__ LAB, const float* __restrict__ CHA, const float* __restrict__ CHB, const bf16_t* __restrict__ gate, bf16_t* __restrict__ yg, int tid) {
    const int gstepT = GRID_N * NTHREADS;
    for (int it = BLOCK_ID * NTHREADS + tid; it < NCH * 2048; it += gstepT) {
        const int c = it & 2047, ch = it >> 11; float hf[CHL];
        float cf = 0.f, cb = 0.f;
        for (int q0 = 0; q0 < ch; q0 += 32) { float a_[32], b_[32];
#pragma unroll
            for (int i = 0; i < 32; ++i) { const int q = (q0 + i < ch) ? q0 + i : ch - 1; const size_t o = ((size_t)0 * NCH + q) * 2048 + c; a_[i] = CHA[o]; b_[i] = CHB[o]; }
            asm volatile("" ::: "memory");
#pragma unroll
            for (int i = 0; i < 32; ++i) cf = (q0 + i < ch) ? a_[i] * cf + b_[i] : cf; }
        for (int q0 = NCH - 1; q0 > ch; q0 -= 32) { float a_[32], b_[32];
#pragma unroll
            for (int i = 0; i < 32; ++i) { const int q = (q0 - i > ch) ? q0 - i : ch + 1; const size_t o = ((size_t)1 * NCH + q) * 2048 + c; a_[i] = CHA[o]; b_[i] = CHB[o]; }
            asm volatile("" ::: "memory");
#pragma unroll
            for (int i = 0; i < 32; ++i) cb = (q0 - i > ch) ? a_[i] * cb + b_[i] : cb; }
        { float h = cf; const unsigned* base = LAB + ((size_t)0 * S_ + (size_t)ch * CHL) * 2048 + c; unsigned wf[CHL];
#pragma unroll
          for (int s = 0; s < CHL; ++s) wf[s] = base[(size_t)s * 2048];
          asm volatile("" ::: "memory");
#pragma unroll
          for (int s = 0; s < CHL; s += 16) asm volatile("" : "+v"(wf[s]), "+v"(wf[s + 1]), "+v"(wf[s + 2]), "+v"(wf[s + 3]), "+v"(wf[s + 4]), "+v"(wf[s + 5]), "+v"(wf[s + 6]), "+v"(wf[s + 7]),
                                                             "+v"(wf[s + 8]), "+v"(wf[s + 9]), "+v"(wf[s + 10]), "+v"(wf[s + 11]), "+v"(wf[s + 12]), "+v"(wf[s + 13]), "+v"(wf[s + 14]), "+v"(wf[s + 15]));
#pragma unroll
          for (int s = 0; s < CHL; ++s) { h = __expf(bflo(wf[s])) * h + bfhi(wf[s]); hf[s] = h; } }
        { float h = cb; const unsigned* base = LAB + ((size_t)1 * S_ + (size_t)ch * CHL) * 2048 + c; const size_t gb = ((size_t)ch * CHL) * 2048 + c; unsigned wb[CHL]; bf16_t gv[CHL];
#pragma unroll
          for (int s = 0; s < CHL; ++s) { wb[s] = base[(size_t)s * 2048]; gv[s] = gate[gb + (size_t)s * 2048]; }
          asm volatile("" ::: "memory");
#pragma unroll
          for (int s = CHL - 1; s >= 0; --s) { h = __expf(bflo(wb[s])) * h + bfhi(wb[s]); yg[gb + (size_t)s * 2048] = f2bf((hf[s] + h) * bf2f(gv[s])); } }
    }
}

__device__ __forceinline__ void diff_combine(const bf16_t* O, const float* lq1, const float* lk1, const float* lq2, const float* lk2, const float* subg, float lam_init, bf16_t* OD, int tid) {
    const int lane = tid & 63, wid = tid >> 6;
    const float s1 = wave_sum(lq1[lane] * lk1[lane] + lq1[lane + 64] * lk1[lane + 64]), s2 = wave_sum(lq2[lane] * lk2[lane] + lq2[lane + 64] * lk2[lane + 64]);
    const float lam = expf(s1) - expf(s2) + lam_init;
    const int half = lane >> 5, d = (lane & 31) * 4; const f32x4 gv = *(const f32x4*)(subg + half * 128 + d);
    const int gstep8 = GRID_N * 8;
    for (int it = BLOCK_ID * 8 + wid; it < S_ * 8; it += gstep8) { const int t = it >> 3, h = it & 7;
        const u32x2 a0 = *(const u32x2*)(O + (size_t)t * 4096 + ((h * 2 + 0) * 2 + half) * 128 + d), a1 = *(const u32x2*)(O + (size_t)t * 4096 + ((h * 2 + 1) * 2 + half) * 128 + d);
        f32x4 o; o[0] = bflo(a0.x) - lam * bflo(a1.x); o[1] = bfhi(a0.x) - lam * bfhi(a1.x); o[2] = bflo(a0.y) - lam * bflo(a1.y); o[3] = bfhi(a0.y) - lam * bfhi(a1.y);
        const float ss = wave_sum(o[0] * o[0] + o[1] * o[1] + o[2] * o[2] + o[3] * o[3]); const float sc = rsqrtf(ss * (1.0f / 256.0f) + NORM_EPS) * (1.0f - lam_init);
        u32x2 w; w.x = cvt_pk_bf16(o[0] * sc * gv[0], o[1] * sc * gv[1]); w.y = cvt_pk_bf16(o[2] * sc * gv[2], o[3] * sc * gv[3]);
        *(u32x2*)(OD + (size_t)t * 2048 + h * 256 + half * 128 + d) = w; }
}

__device__ __forceinline__ void s5_carry(const float* __restrict__ SL, const float* __restrict__ lam16, bf16_t* __restrict__ UA, LAS unsigned char* lds, int tid) {
    LAS float* ex = (LAS float*)lds;
    const int cl = tid & 31, seg = tid >> 5; const int gstep = GRID_N;
    for (int item = BLOCK_ID; item < 256; item += gstep) {
        const int chain = item * 32 + cl, g = chain >> 7, dn = chain & 127, dir = dn >> 6, n = dn & 63;
        const float lr = lam16[(((size_t)g * 2 + dir) * 64 + n) * 2], li = lam16[(((size_t)g * 2 + dir) * 64 + n) * 2 + 1];
        const int nidx = dir * 128 + 2 * n;
        const float* sl = SL + (size_t)g * 512 * 256 + nidx; bf16_t* ua = UA + (size_t)g * 512 * 512 + 256 + nidx;
        f32x2 e[32];
#pragma unroll
        for (int s_ = 0; s_ < 32; ++s_) { const int q = seg * 32 + s_, c = dir ? (511 - q) : q; e[s_] = *(const f32x2*)(sl + (size_t)c * 256); }
        float sr = 0.f, si = 0.f;
#pragma unroll
        for (int s_ = 0; s_ < 32; ++s_) { const float tr = lr * sr - li * si + e[s_][0]; si = lr * si + li * sr + e[s_][1]; sr = tr; }
        ex[(cl * 16 + seg) * 2] = sr; ex[(cl * 16 + seg) * 2 + 1] = si;
        float mr = lr, mi = li;
#pragma unroll
        for (int k = 0; k < 5; ++k) { const float tr = mr * mr - mi * mi; mi = 2.f * mr * mi; mr = tr; }
        __syncthreads();
        float cr = 0.f, ci = 0.f;
        for (int p_ = 0; p_ < seg; ++p_) { const float er = ex[(cl * 16 + p_) * 2], ei = ex[(cl * 16 + p_) * 2 + 1]; const float tr = mr * cr - mi * ci + er; ci = mr * ci + mi * cr + ei; cr = tr; }
        sr = cr; si = ci;
#pragma unroll
        for (int s_ = 0; s_ < 32; ++s_) { const int q = seg * 32 + s_, c = dir ? (511 - q) : q;
            *(unsigned*)(ua + (size_t)c * 512) = cvt_pk_bf16(sr, si);
            const float tr = lr * sr - li * si + e[s_][0]; si = lr * si + li * sr + e[s_][1]; sr = tr; }
        __syncthreads();
    }
}

template <bool GATHER_>
struct MoeSched {
    static constexpr bool GATHER = GATHER_;
    const LAS int* tle; const LAS int* tli; const LAS int* lc; const int* rowtok; const char* A; const char* W; size_t a_tile, b_tile; int ntiles, nN, G, c, rep;
    __device__ __forceinline__ int my_units() const { if (G != 256) { const long n = (long)ntiles * nN; return (int)((n - c + G - 1) / G > 0 ? (n - c + G - 1) / G : 0); }
        const int x = c & 7, k = c >> 3; int cnt; if (nN == 4) { const int h0 = (ntiles + 1) >> 1; cnt = (x >> 2) ? ntiles - h0 : h0; } else cnt = ntiles; return cnt > k ? (cnt - k + 31) >> 5 : 0; }
    __device__ __forceinline__ int max_units() const { if (G != 256) return (int)(((long)ntiles * nN + G - 1) / G); const int cnt = (nN == 4) ? (ntiles + 1) >> 1 : ntiles; return (cnt + 31) >> 5; }
    __device__ __forceinline__ bool next(int i, pg::Unit& u) const {
        int rt, pn;
        if (G == 256) { const int x = c & 7, k = c >> 3, j = (i % (my_units() > 0 ? my_units() : 1)) * 32 + k; if (i >= my_units() * rep) return false;
            if (nN == 4) { const int h0 = (ntiles + 1) >> 1; pn = x & 3; rt = ((x >> 2) ? h0 : 0) + j; } else { pn = x; rt = j; } }
        else { const long L0 = (long)i * G + c; if (L0 >= (long)ntiles * nN * rep) return false; const long L = L0 % ((long)ntiles * nN); rt = (int)(L / nN); pn = (int)(L % nN); }
        u.pn = pn; u.aux = rt; u.g = tle[rt]; u.pm = tli[rt]; return true;
    }
    __device__ __forceinline__ const char* a_base(const pg::Unit& u) const { return GATHER ? A : A + (size_t)u.aux * a_tile; }
    __device__ __forceinline__ const char* b_base(const pg::Unit& u) const { return W + (size_t)u.g * MOE_LE_B + (size_t)u.pn * b_tile; }
    __device__ __forceinline__ int a_row(const pg::Unit& u, int r) const { const int idx = u.pm * 256 + r; return (idx < lc[u.g]) ? rowtok[u.g * 8192 + idx] : S_; }
};
#ifndef CFG_MIX
#define CFG_MIX 0xF
#endif
#ifndef CFG_MOE
#define CFG_MOE 0xF
#endif
constexpr int NPH = 37;
#ifndef PH_MASK
#define PH_MASK 0xFFFFFFFFFFFFFFFFull
#endif
#ifndef DBL_MASK
#define DBL_MASK 0ull
#endif
#ifndef ATT_REP
#define ATT_REP 1
#endif
#define SREP(k) (((((unsigned long long)DBL_MASK >> (k)) & 1ull)) ? 2 : 1)
#define REP(k) _Pragma("nounroll") for (int rep_ = 0; rep_ < ((((unsigned long long)DBL_MASK >> (k)) & 1ull) ? 2 : 1); ++rep_)

#define PH_ENV CArgs* ap = kargs(); unsigned char* ws = ap->ws; (void)ws; const int tid = TID(); (void)tid; const int G = ap->grid; (void)G;
#define XP      ((bf16_t*)(ws + WS_X))
#define HP      ((bf16_t*)(ws + WS_H))
#define RSP     ((float*)(ws + WS_RS))
#define RSGP    ((float*)(ws + WS_RSG))
#define ROWTOK  ((int*)(ws + WS_ROWTOK))
#define TOPE    ((int*)(ws + WS_TOPE))
#define TOPW    ((float*)(ws + WS_TOPW))
#define SLOTP   ((int*)(ws + WS_SLOT))
#define HDN     ((bf16_t*)(ws + WS_HDN))
#define YSB     ((bf16_t*)(ws + WS_YS))
#define CNTL(L) ((unsigned*)(ws + CTL_CNT) + (L) * 512)
#define ARP(off) (ws + WS_ARENA + (off))

#define TAIL_IDLE(n) ((((n) + G - 1) / G - 1) * G + bid >= (n))
#ifndef TQ_MOE1
#define TQ_MOE1 32
#define TQ_MOE2 8
#define TQ_WINQKV 32
#define TQ_S5IN 32
#define TQ_S5E 4
#define TQ_S5TF 8
#define TQ_S5GLU 16
#endif
#define MOE_BLOCK(L, p0, GNEXT_IDX, GNEXT_OFF, FINAL)                                                                                            \
    if (IN(p0)) { if ((CFG_MOE >> (L)) & 1) { PH_ENV if ((L) >= 1) catchup_convert(ap, lds, (L) * MOE_LAYER_TILES + MOE_GU_TILES, tid); router_phase(XP, RSGP, (const float*)(ws + WS_WRT) + (size_t)(L) * 36 * 2048, \
            TOPE, TOPW, SLOTP, ROWTOK, CNTL(L), lds, tid); } SEAM(p0); }                        \
    if (IN((p0) + 1)) { if ((CFG_MOE >> (L)) & 1) { PH_ENV moe_table(CNTL(L), lds, tid);                                                         \
            MoeSched<true> Sm; Sm.tle = (const LAS int*)(lds + LDS_TLE); Sm.tli = (const LAS int*)(lds + LDS_TLI); Sm.lc = (const LAS int*)(lds + LDS_CNT); Sm.rowtok = ROWTOK; \
            Sm.A = (const char*)XP; Sm.W = (const char*)(ws + WS_W_MOE + (size_t)(L) * 32 * MOE_LE_B); Sm.a_tile = 0; Sm.b_tile = (size_t)256 * 2048 * 2;  \
            Sm.ntiles = *(const LAS int*)(lds + LDS_NT); Sm.nN = 4; Sm.G = G; Sm.c = bid; Sm.rep = SREP((p0) + 1);                                                        \
            ep::MoeGU E{HDN, RSGP, (const LAS int*)(lds + LDS_CNT)}; pg::gemm_phase(lds, Sm, E, 2048, 2048, 2048, tid);                                                                        \
            if (Sm.my_units() < Sm.max_units()) tail_convert(ap, lds, TQ_MOE1, tid);                                                                    \
            catchup_convert(ap, lds, ((L) + 1) * MOE_LAYER_TILES, tid); } SEAM((p0) + 1); }                                                        \
    if (IN((p0) + 2)) { if ((CFG_MOE >> (L)) & 1) { PH_ENV if (MK_SPLIT) moe_table(CNTL(L), lds, tid);                                                         \
            MoeSched<false> Sm; Sm.tle = (const LAS int*)(lds + LDS_TLE); Sm.tli = (const LAS int*)(lds + LDS_TLI); Sm.lc = (const LAS int*)(lds + LDS_CNT); Sm.rowtok = ROWTOK; \
            Sm.A = (const char*)HDN; Sm.W = (const char*)(ws + WS_W_MOE + (size_t)(L) * 32 * MOE_LE_B + MOE_GU_B); Sm.a_tile = (size_t)256 * 512 * 2; Sm.b_tile = (size_t)256 * 512 * 2; \
            Sm.ntiles = *(const LAS int*)(lds + LDS_NT); Sm.nN = 8; Sm.G = G; Sm.c = bid; Sm.rep = SREP((p0) + 2);                                                        \
            ep::MoeDown E{YSB}; pg::gemm_phase(lds, Sm, E, 512, 512, 512, tid);                                                                          \
            if ((L) <= 2 && Sm.my_units() < Sm.max_units()) tail_convert(ap, lds, TQ_MOE2, tid); } SEAM((p0) + 2); }                                                    \
    if (IN((p0) + 3)) { PH_ENV if ((CFG_MOE >> (L)) & 1) norm_phase<1, FINAL, true>(XP, (FINAL) ? nullptr : XP, ap->in[GNEXT_IDX] + (GNEXT_OFF), HP, RSP, ap->out, YSB, TOPE, TOPW, SLOTP, CNTL(L), lds, tid); \
                        else norm_phase<0, FINAL, true>(XP, nullptr, ap->in[GNEXT_IDX] + (GNEXT_OFF), HP, RSP, ap->out, nullptr, nullptr, nullptr, nullptr, nullptr, lds, tid); SEAM((p0) + 3); }

__global__ void __launch_bounds__(NTHREADS, 2) mega(Args a_unused) {
    extern __shared__ __attribute__((aligned(16))) unsigned char lds_raw[];
    LAS unsigned char* lds = (LAS unsigned char*)lds_raw;
    const int wave_s = __builtin_amdgcn_readfirstlane(threadIdx.x >> 6);
    const int bid = __builtin_amdgcn_workgroup_id_x();
    int lo, hi, gsz; unsigned* barw;
    { PH_ENV lo = ap->ph_lo; hi = ap->ph_hi; gsz = G; barw = (unsigned*)(ws + CTL_BAR);
      if (tid < 4) ((LAS unsigned*)(lds + LDS_MISC))[tid] = 0u; }
    __syncthreads();
    XcdBarrier bar; bar.bar = barw; bar.x = 0; bar.st = (volatile LAS unsigned*)(lds + LDS_MISC); bar.G = (unsigned)gsz;
    if (hi - lo > 1) bar = xcd_barrier_post(barw, (volatile LAS unsigned*)(lds + LDS_MISC), TID(), (unsigned)gsz);
#define IN(k) ((((unsigned long long)PH_MASK >> (k)) & 1ull) && lo <= (k) && (k) < hi)
#define SEAM(k) do { if ((k) + 1 < hi) { xcd_barrier(bar, TID()); if (BAR_REP > 1) xcd_barrier(bar, TID()); } } while (0)

    if (IN(0)) REP(0) { PH_ENV
        if (bid < 64) s5_tables(ap, lds, bid, tid);
        prologue_weights(ap, lds, tid);
        norm_phase<0, false, false>(ap->in[I_X], ((CFG_MIX & 1) ? nullptr : XP), ap->in[I_LN_MIX], HP, RSP, nullptr, nullptr, nullptr, nullptr, nullptr, nullptr, lds, tid);
    }
    if (IN(0)) SEAM(0);
    {
#define GATE ((bf16_t*)ARP(AR_GATE))
#define XRP_ ((bf16_t*)ARP(AR_XRP))
#define XR_  ((bf16_t*)ARP(AR_XR))
#define YG_  ((bf16_t*)ARP(AR_YG))
#define LAB_ ((unsigned*)ARP(AR_LAB))
#define CHA_ ((float*)ARP(AR_CHA))
#define CHB_ ((float*)ARP(AR_CHB))
#define CAR_ ((float*)ARP(AR_CAR))
        constexpr bool ON = (CFG_MIX >> 0) & 1;
        if (IN(1)) { if (ON) { PH_ENV pg::DenseSched Sd; Sd.init(HP, ws + WS_W_LRU_IN, S_, 4096, 2048, 2048, G, bid); Sd.rep = SREP(1); ep::LruIn E{GATE, XRP_, RSP}; pg::gemm_phase(lds, Sd, E, 2048, 2048, 2048, tid); } SEAM(1); }
        if (IN(2)) { if (ON) REP(2) { PH_ENV lru_conv_phase(XRP_, ap->in[I_LRU_CONV_W], ap->in[I_LRU_CONV_B], XR_, tid); } SEAM(2); }
        if (IN(3)) { if (ON) { PH_ENV pg::GroupSched Sg; Sg.init(XR_, ws + WS_W_LRU_G, 8, S_, 1024, 2048, 256, (size_t)256 * 2, (size_t)1024 * 256 * 2, G, bid); Sg.rep = SREP(3);
                ep::LruGates E{XR_, ap->in[I_LRU_B_A], ap->in[I_LRU_B_X], (const float*)(ws + WS_SPT), LAB_}; pg::gemm_phase(lds, Sg, E, 256, 2048, 256, tid); } SEAM(3); }
        if (IN(4)) { if (ON) REP(4) { PH_ENV lru_scan1(LAB_, CHA_, CHB_, tid); } SEAM(4); }
        if (IN(6)) { if (ON) REP(6) { PH_ENV lru_scan3(LAB_, CHA_, CHB_, GATE, YG_, tid); } SEAM(6); }
        if (IN(7)) { if (ON) { PH_ENV pg::DenseSched Sd; Sd.init(YG_, ws + WS_W_LRU_O, S_, 2048, 2048, 2048, G, bid); Sd.rep = SREP(7); ep::Resid<false> E{HP, XP, 2048, nullptr}; pg::gemm_phase(lds, Sd, E, 2048, 2048, 2048, tid); } SEAM(7); }
    }
    MOE_BLOCK(0, 8, I_LN_MIX, 1 * 2048, false)
    {
#define AQ ((bf16_t*)ARP(AR_Q))
#define AK ((bf16_t*)ARP(AR_K))
#define AV ((bf16_t*)ARP(AR_V))
#define AO ((bf16_t*)ARP(AR_O))
#define AOD ((bf16_t*)ARP(AR_OD))
        constexpr bool ON = (CFG_MIX >> 1) & 1;
        if (IN(12)) { if (ON) { PH_ENV pg::DenseSched Sd; Sd.init(XP, ws + WS_W_DF_QKV, S_, 6144, 2048, 2048, G, bid); Sd.rep = SREP(12);
                ep::QkvRope E{AQ, AK, AV, 2048, 4096, (const float*)(ws + WS_ROPE), RSP}; pg::gemm_phase(lds, Sd, E, 2048, 2048, 2048, tid); } SEAM(12); }
        if (IN(13)) { if (ON) { PH_ENV
                const int lane_ = tid & 63; const float* lq1 = ap->in[I_DIFF_LQ1]; const float* lk1 = ap->in[I_DIFF_LK1]; const float* lq2 = ap->in[I_DIFF_LQ2]; const float* lk2 = ap->in[I_DIFF_LK2];
                const float s1_ = wave_sum(lq1[lane_] * lk1[lane_] + lq1[lane_ + 64] * lk1[lane_ + 64]), s2_ = wave_sum(lq2[lane_] * lk2[lane_] + lq2[lane_ + 64] * lk2[lane_ + 64]);
                constexpr float lam_init = 0.8f - 0.6f * 0.7408182206817179f; if (tid == 0) ((LAS float*)(lds + att::B2_LAM))[0] = expf(s1_) - expf(s2_) + lam_init; __syncthreads();
                for (int L0 = bid; L0 < 256 * ATT_REP; L0 += G) { const int L = L0 & 255; const int h = L & 7, qb = L >> 3;
                    float* scr = (float*)ARP(AR_O) + (size_t)bid * (512 * 128);
                    att::body2<128, 128, 128, 2048, 1>(AQ + ((size_t)(h * 2) * S_ + (size_t)qb * 256) * 128, AK + (size_t)(h * 2) * S_ * 128, AV + (size_t)(h * 2) * S_ * 128, AV + (size_t)(h * 2 + 1) * S_ * 128,
                                                       nullptr, 128, (LAS char*)lds, TID(), scr, 0.f, nullptr, 0.f);
                    att::body2<128, 128, 128, 2048, 2>(AQ + ((size_t)(h * 2 + 1) * S_ + (size_t)qb * 256) * 128, AK + (size_t)(h * 2 + 1) * S_ * 128, AV + (size_t)(h * 2) * S_ * 128, AV + (size_t)(h * 2 + 1) * S_ * 128,
                                                       AOD + (size_t)qb * 256 * 2048 + h * 256, 128, (LAS char*)lds, TID(), scr, 0.f, ap->in[I_DIFF_SUBLN], 1.0f - lam_init); } } SEAM(13); }
        if (IN(15)) { if (ON) { PH_ENV pg::DenseSched Sd; Sd.init(AOD, ws + WS_W_DF_O, S_, 2048, 2048, 2048, G, bid); Sd.rep = SREP(15); ep::Resid<false> E{XP, XP, 2048, nullptr}; pg::gemm_phase(lds, Sd, E, 2048, 2048, 2048, tid); } SEAM(15); }
    }
    MOE_BLOCK(1, 16, I_LN_MIX, 2 * 2048, false)
    {
        constexpr bool ON = (CFG_MIX >> 2) & 1;
        if (IN(20)) { if (ON) { PH_ENV pg::DenseSched Sd; Sd.init(XP, ws + WS_W_WN_QKV, S_, 3072, 2048, 2048, G, bid); Sd.rep = SREP(20);
                ep::QkvRope E{AQ, AK, AV, 2048, 2560, (const float*)(ws + WS_ROPE), RSP}; pg::gemm_phase(lds, Sd, E, 2048, 2048, 2048, tid);
                if (TAIL_IDLE(384)) tail_convert(ap, lds, TQ_WINQKV, tid); } SEAM(20); }
        if (IN(21)) { if (ON) { PH_ENV const float* sink = ap->in[I_WIN_SINK];
                for (int L = bid; L < 512; L += G) { const int head = (L >> 8) * 8 + (L & 7), qb = (L & 255) >> 3, kvh = head >> 2; const int q0 = qb * 256;
                    const int klo = q0 - 128 < 0 ? 0 : q0 - 128, khi = q0 + 384 > S_ ? S_ : q0 + 384;
                    att::body<128, 128, 128, 2048, true, 0>(AQ + ((size_t)head * S_ + q0) * 128, AK + ((size_t)kvh * S_ + klo) * 128, AV + ((size_t)kvh * S_ + klo) * 128,
                                                          AO + (size_t)q0 * 2048 + head * 128, (khi - klo) / 64, (LAS char*)lds, q0, klo, sink[head] * (1.0f / att::SCALE), tid); } } SEAM(21); }
        if (IN(22)) { if (ON) { PH_ENV pg::DenseSched Sd; Sd.init(AO, ws + WS_W_WN_O, S_, 2048, 2048, 2048, G, bid); Sd.rep = SREP(22); ep::Resid<false> E{XP, XP, 2048, nullptr}; pg::gemm_phase(lds, Sd, E, 2048, 2048, 2048, tid); } SEAM(22); }
    }
    MOE_BLOCK(2, 23, I_LN_MIX, 3 * 2048, false)
    {
#define SU  ((float*)ARP(AR_U))
#define SUA ((bf16_t*)ARP(AR_UA))
#define SSL ((float*)ARP(AR_SL))
#define SG  ((bf16_t*)ARP(AR_G))
#define SZ  ((bf16_t*)ARP(AR_Z))
        constexpr bool ON = (CFG_MIX >> 3) & 1;
        if (IN(27)) { if (ON) { PH_ENV pg::DenseSched Sd; Sd.init(XP, ws + WS_W_S5_IN, S_, 1024, 2048, 2048, G, bid); Sd.rep = SREP(27); ep::S5In E{SU, SUA, RSP}; pg::gemm_phase(lds, Sd, E, 2048, 2048, 2048, tid); if (TAIL_IDLE(128)) tail_convert(ap, lds, TQ_S5IN, tid); } SEAM(27); }
        if (IN(28)) { if (ON) { PH_ENV pg::GroupSched Sg; Sg.init(SUA, ws + WS_S5_E, 64, 512, 256, 512, 256, (size_t)512 * 512 * 2, (size_t)256 * 256 * 2, G, bid); Sg.rep = SREP(28);
                ep::F32Group E{SSL, 256, (size_t)512 * 256}; pg::gemm_phase(lds, Sg, E, 256, 512, 256, tid); if (TAIL_IDLE(128)) tail_convert(ap, lds, TQ_S5E, tid); } SEAM(28); }
        if (IN(29)) { if (ON) REP(29) { PH_ENV s5_carry(SSL, (const float*)(ws + WS_S5_LAM), SUA, lds, tid); } SEAM(29); }
        if (IN(30)) { if (ON) { PH_ENV pg::GroupSched Sg; Sg.init(SUA, ws + WS_S5_TF, 64, 512, 256, 512, 512, (size_t)512 * 512 * 2, (size_t)256 * 512 * 2, G, bid); Sg.rep = SREP(30);
                ep::S5Y E{SU, ap->in[I_S5_D], SG}; pg::gemm_phase(lds, Sg, E, 512, 512, 512, tid); if (TAIL_IDLE(128)) tail_convert(ap, lds, TQ_S5TF, tid); } SEAM(30); }
        if (IN(31)) { if (ON) { PH_ENV pg::DenseSched Sd; Sd.init(SG, ws + WS_W_S5_GLU, S_, 1024, 1024, 1024, G, bid); Sd.rep = SREP(31); ep::S5Glu E{SG, SZ}; pg::gemm_phase(lds, Sd, E, 1024, 1024, 1024, tid); if (TAIL_IDLE(128)) tail_convert(ap, lds, TQ_S5GLU, tid); } SEAM(31); }
        if (IN(32)) { if (ON) { PH_ENV pg::DenseSched Sd; Sd.init(SZ, ws + WS_W_S5_O, S_, 2048, 1024, 1024, G, bid); Sd.rep = SREP(32); ep::Resid<false> E{XP, XP, 2048, nullptr}; pg::gemm_phase(lds, Sd, E, 1024, 1024, 1024, tid); } SEAM(32); }
    }
    MOE_BLOCK(3, 33, I_LN_FINAL, 0, true)
#undef IN
#undef SEAM
}

extern "C" void kernel_launch(void* const* d_in, const int* in_sizes, int n_in, void* d_out, int out_size, void* d_ws, size_t ws_size, hipStream_t stream) {
    static int grid = 0;
    if (grid == 0) {
        if (n_in != N_INPUTS || out_size != S_ * D_ || ws_size < WS_END) { fprintf(stderr, "kernel_launch: unexpected shapes (n_in %d out %d ws %zu need %zu)\n", n_in, out_size, ws_size, (size_t)WS_END); grid = -1; return; }
        int dev = 0, cus = 0, per_cu = 0;
        if (hipGetDevice(&dev) != hipSuccess || hipDeviceGetAttribute(&cus, hipDeviceAttributeMultiprocessorCount, dev) != hipSuccess) { grid = -1; return; }
        if (hipFuncSetAttribute((const void*)mega, hipFuncAttributeMaxDynamicSharedMemorySize, LDS_BYTES) != hipSuccess) { fprintf(stderr, "kernel_launch: hipFuncSetAttribute failed\n"); grid = -1; return; }
        if (hipOccupancyMaxActiveBlocksPerMultiprocessor(&per_cu, (const void*)mega, NTHREADS, LDS_BYTES) != hipSuccess || per_cu < 1) { fprintf(stderr, "kernel_launch: occupancy query says %d\n", per_cu); }
        (void)hipGetLastError();
        grid = cus;
    }
    if (grid < 0) return;
    (void)hipMemsetAsync((char*)d_ws + WS_CTL, 0, CTL_BYTES, stream);
    Args a{};
    for (int i = 0; i < N_INPUTS; ++i) a.in[i] = (const float*)d_in[i];
    a.out = (float*)d_out; a.ws = (unsigned char*)d_ws;
    unsigned char* ws = (unsigned char*)d_ws;
    const DenseW dws[10] = {
        {a.in[I_LRU_W_IN],  (bf16_t*)(ws + WS_W_LRU_IN), 2048, 4096, a.in[I_LN_MIX]}, {a.in[I_LRU_W_OUT],  (bf16_t*)(ws + WS_W_LRU_O), 2048, 2048, nullptr},
        {a.in[I_DIFF_W_QKV], (bf16_t*)(ws + WS_W_DF_QKV), 2048, 6144, a.in[I_LN_MIX] + 2048}, {a.in[I_DIFF_W_OUT], (bf16_t*)(ws + WS_W_DF_O), 2048, 2048, nullptr},
        {a.in[I_WIN_W_QKV],  (bf16_t*)(ws + WS_W_WN_QKV), 2048, 3072, a.in[I_LN_MIX] + 2 * 2048}, {a.in[I_WIN_W_OUT],  (bf16_t*)(ws + WS_W_WN_O), 2048, 2048, nullptr},
        {a.in[I_S5_W_IN],    (bf16_t*)(ws + WS_W_S5_IN), 2048, 1024, a.in[I_LN_MIX] + 3 * 2048},  {a.in[I_S5_W_GLU],   (bf16_t*)(ws + WS_W_S5_GLU), 1024, 1024, nullptr},
        {a.in[I_S5_W_OUT],   (bf16_t*)(ws + WS_W_S5_O), 1024, 2048, nullptr},   {a.in[I_S5_W_OUT],   (bf16_t*)(ws + WS_W_S5_O), 1024, 0, nullptr} };
    for (int i = 0; i < 10; ++i) a.dw[i] = dws[i];
#if MK_SPLIT
    a.grid = grid;
    for (int p = 0; p < NPH; ++p) { a.ph_lo = p; a.ph_hi = p + 1; hipLaunchKernelGGL(mega, dim3(grid), dim3(NTHREADS), LDS_BYTES, stream, a); }
#else
    a.grid = grid; a.ph_lo = 0; a.ph_hi = NPH; hipLaunchKernelGGL(mega, dim3(grid), dim3(NTHREADS), LDS_BYTES, stream, a);
#endif
}
```

```cpp
#include <hip/hip_runtime.h>
#include <cstdio>
#include <cstdint>

#define LAS __attribute__((address_space(3)))
typedef unsigned short bf16_t;
typedef short bf16x8 __attribute__((ext_vector_type(8)));
typedef short s16x4 __attribute__((ext_vector_type(4)));
typedef float f32x2 __attribute__((ext_vector_type(2)));
typedef float f32x4 __attribute__((ext_vector_type(4)));
typedef float f32x8 __attribute__((ext_vector_type(8)));
typedef float f32x16 __attribute__((ext_vector_type(16)));
typedef unsigned u32x2 __attribute__((ext_vector_type(2)));
typedef unsigned u32x4 __attribute__((ext_vector_type(4)));

#ifndef BAR_REP
#define BAR_REP 1
#endif
#ifndef ROUTER_REP
#define ROUTER_REP 1
#endif
constexpr int S_ = 8192, D_ = 2048, NTHREADS = 512;
constexpr int N_EXP = 32, D_EXP = 512;
constexpr float NORM_EPS = 1e-6f;
#ifndef MK_SPLIT
#define MK_SPLIT 0
#endif
constexpr int MAXTILES = 96;
constexpr int NCH = 128, CHL = 64;

__device__ __forceinline__ unsigned cvt_pk_bf16(float lo, float hi) { unsigned r; asm volatile("v_cvt_pk_bf16_f32 %0, %1, %2" : "=v"(r) : "v"(lo), "v"(hi)); return r; }
__device__ __forceinline__ bf16_t f2bf(float x) { return (bf16_t)(cvt_pk_bf16(x, x) & 0xffffu); }
__device__ __forceinline__ float bf2f(bf16_t b) { return __uint_as_float(((unsigned)b) << 16); }
__device__ __forceinline__ float bflo(unsigned w) { return __uint_as_float(w << 16); }
__device__ __forceinline__ float bfhi(unsigned w) { return __uint_as_float(w & 0xffff0000u); }
__device__ __forceinline__ float sigmoidf_(float x) { return __builtin_amdgcn_rcpf(1.0f + __expf(-x)); }
__device__ __forceinline__ float gelu_tanh(float v) { const float u = 1.5957691216057308f * (v + 0.044715f * v * v * v); return v * __builtin_amdgcn_rcpf(1.0f + __expf(-u)); }
__device__ __forceinline__ f32x2 exp2_2(const f32x2 x) { return (f32x2){__builtin_amdgcn_exp2f(x[0]), __builtin_amdgcn_exp2f(x[1])}; }
__device__ __forceinline__ f32x2 rcp_2(const f32x2 x) { return (f32x2){__builtin_amdgcn_rcpf(x[0]), __builtin_amdgcn_rcpf(x[1])}; }
__device__ __forceinline__ f32x2 sigmoid_2(const f32x2 x) { return rcp_2(exp2_2(x * (-1.4426950408889634f)) + 1.0f); }
__device__ __forceinline__ f32x2 gelu_tanh_2(const f32x2 v) {
    const f32x2 w = (v * v) * (-1.4426950408889634f * 1.5957691216057308f * 0.044715f) + (-1.4426950408889634f * 1.5957691216057308f);
    return v * rcp_2(exp2_2(v * w) + 1.0f); }
#define LO2(x) ((f32x2){(x)[0], (x)[1]})
#define HI2(x) ((f32x2){(x)[2], (x)[3]})
__device__ __forceinline__ float wave_sum(float v) {
#pragma unroll
    for (int o = 32; o >= 1; o >>= 1) v += __shfl_xor(v, o);
    return v;
}

#define XB_TMO      128
#define XB_XCNT(j)  (256  + 64 * (j))
#define XB_XSUB(j)  (1280 + 64 * (j))
#define XB_XGEN(j)  (2304 + 64 * (j))
#define XB_TOP      3328
#define XB_TOPGEN   3392
#define XCD_BAR_WORDS 3456
#define XB_SPIN_CAP (1u << 18)
__device__ __forceinline__ unsigned xb_ld(unsigned* p)              { return __hip_atomic_load(p, __ATOMIC_RELAXED, __HIP_MEMORY_SCOPE_AGENT); }
__device__ __forceinline__ unsigned xb_add(unsigned* p, unsigned v) { return __hip_atomic_fetch_add(p, v, __ATOMIC_RELAXED, __HIP_MEMORY_SCOPE_AGENT); }
__device__ __forceinline__ unsigned xb_xcc_id() { return (unsigned)__builtin_amdgcn_s_getreg((3 << 11) | 20) & 0xFu; }
#define XB_SPIN(cond, bar) do { unsigned _sp = 0; while (cond) { __builtin_amdgcn_s_sleep(1); \
    if ((++_sp & 255u) == 0u) { if (xb_ld(&(bar)[XB_TMO])) break; if (_sp > XB_SPIN_CAP) { atomicAdd(&(bar)[XB_TMO], 1u); break; } } } } while (0)
struct XcdBarrier { unsigned* bar; unsigned x; volatile LAS unsigned* st; unsigned G; };
__device__ __forceinline__ XcdBarrier xcd_barrier_post(unsigned* bar, volatile LAS unsigned* st, int tid, unsigned G) {
    XcdBarrier b; b.bar = bar; b.x = xb_xcc_id(); b.st = st; b.G = G;
    if (tid == 0) (void)xb_add(&bar[XB_XCNT(b.x)], 1u);
    return b;
}
__device__ __forceinline__ void xcd_barrier_complete(unsigned* bar, unsigned x, unsigned& nloc, unsigned& nx, const unsigned G) {
    unsigned sum, cnt, mine, sp = 0u;
    for (;;) {
        sum = 0u; cnt = 0u; mine = 0u;
#pragma unroll
        for (unsigned j = 0; j < 16; ++j) { const unsigned c = xb_ld(&bar[XB_XCNT(j)]); sum += c; cnt += (c > 0u) ? 1u : 0u; mine = (j == x) ? c : mine; }
        if (sum == G) break;
        __builtin_amdgcn_s_sleep(1);
        if ((++sp & 255u) == 0u) { if (xb_ld(&bar[XB_TMO])) break; if (sp > XB_SPIN_CAP) { atomicAdd(&bar[XB_TMO], 1u); break; } }
    }
    nloc = mine > 0u ? mine : 1u; nx = cnt > 0u ? cnt : 1u;
}
__device__ __forceinline__ void xcd_barrier(const XcdBarrier& b, int tid) {
    asm volatile("s_waitcnt vmcnt(0)" ::: "memory");
    __syncthreads();
    if (tid == 0) {
        unsigned* bar = b.bar;
        __builtin_amdgcn_s_waitcnt(0);
        unsigned nloc = b.st[0], nx = b.st[1];
        if (nloc == 0u) { xcd_barrier_complete(bar, b.x, nloc, nx, b.G); b.st[0] = nloc; b.st[1] = nx; }
        const unsigned old = xb_add(&bar[XB_XSUB(b.x)], 1u);
        const unsigned gen = old / nloc;
        if (old + 1u == (gen + 1u) * nloc) {
            __builtin_amdgcn_fence(__ATOMIC_RELEASE, "agent");
            asm volatile("s_waitcnt vmcnt(0)" ::: "memory");
            const unsigned og = xb_add(&bar[XB_TOP], 1u);
            const unsigned tg = og / nx;
            if (og + 1u == (tg + 1u) * nx) xb_add(&bar[XB_TOPGEN], 1u);
            else XB_SPIN(xb_ld(&bar[XB_TOPGEN]) == tg, bar);
            __builtin_amdgcn_fence(__ATOMIC_ACQUIRE, "agent");
            xb_add(&bar[XB_XGEN(b.x)], 1u);
            asm volatile("s_waitcnt vmcnt(0)" ::: "memory");
        } else {
            XB_SPIN(xb_ld(&bar[XB_XGEN(b.x)]) == gen, bar);
            __builtin_amdgcn_fence(__ATOMIC_ACQUIRE, "agent");
            asm volatile("s_waitcnt vmcnt(0)" ::: "memory");
        }
    }
    __syncthreads();
}

namespace pg {
constexpr int BM = 256, BK = 64, HALF = 128, HTB = HALF * BK * 2, STAGE_BYTES = 8 * HTB;
__device__ __forceinline__ int lds_byte(int r, int c) { const int st = (r >> 4) * 2 + (c >> 5), rr = r & 15, cc = c & 31, ob = rr * 64 + cc * 2; return st * 1024 + (ob ^ (((ob >> 9) & 1) << 5)); }
__device__ __forceinline__ void stage_rc(int b, int& R, int& C) { const int st = b / 1024, sb = b % 1024, swz = sb ^ (((sb >> 9) & 1) << 5); R = (st >> 1) * 16 + swz / 64; C = (st & 1) * 32 + (swz % 64) / 2; }
__device__ __forceinline__ int perm32(int rho) { const int n = rho >> 4, i = rho & 15; return 8 * (i >> 2) + 4 * n + (i & 3); }

struct Unit { int pm, pn, g, aux; };

template <class Epi, class Sched>
__device__ __forceinline__ void gemm_phase(LAS unsigned char* lds, const Sched& S, const Epi& E, const int K, const int lda, const int ldb, const int tid) {
    const int wid = __builtin_amdgcn_readfirstlane(tid >> 6), lane = tid & 63, wr = wid >> 2, wc = wid & 3, fr = lane & 15, fq = lane >> 4;
    const int nt = K / BK;
    int RA[2], CA[2]; unsigned vB[2][2];
#pragma unroll
    for (int i = 0; i < 2; ++i) { int R, C; stage_rc(tid * 16 + i * 8192, R, C); RA[i] = R; CA[i] = C; const int Rb = Epi::PERM ? ((R & ~31) + perm32(R & 31)) : R;
        vB[0][i] = (unsigned)(Rb * ldb + C) * 2u; vB[1][i] = (unsigned)((Rb + HALF) * ldb + C) * 2u; }
    const size_t kstep = (size_t)(BK * 2);
    const unsigned ldsw = (unsigned)wid * 1024u;
    const int aoff = lds_byte(wr * 64 + fr, fq * 8), boff = lds_byte(wc * 32 + fr, fq * 8);
#define PG_SA(b, h) (((b) * 2 + (h)) * HTB)
#define PG_SB(b, h) ((4 + (b) * 2 + (h)) * HTB)
#define PG_STAGE(bufoff, gbase, voff) do { _Pragma("unroll") for (int _i = 0; _i < 2; ++_i) \
        __builtin_amdgcn_global_load_lds((const unsigned*)((const char*)(gbase) + (voff)[_i]), (LAS unsigned*)(lds + (bufoff) + ldsw + _i * 8192), 16, 0, 0); } while (0)
#define PG_LDA(dst, b, h) do { _Pragma("unroll") for (int m = 0; m < 4; ++m) _Pragma("unroll") for (int k = 0; k < 2; ++k) dst[m][k] = *(const LAS bf16x8*)(lds + PG_SA(b, h) + aoff + m * 2048 + k * 1024); } while (0)
#define PG_LDB(dst, b, h) do { _Pragma("unroll") for (int n = 0; n < 2; ++n) _Pragma("unroll") for (int k = 0; k < 2; ++k) dst[n][k] = *(const LAS bf16x8*)(lds + PG_SB(b, h) + boff + n * 2048 + k * 1024); } while (0)
#define PG_MMA(ai, bj, At, Bt) do { __builtin_amdgcn_s_setprio(1); _Pragma("unroll") for (int m = 0; m < 4; ++m) _Pragma("unroll") for (int n = 0; n < 2; ++n) _Pragma("unroll") for (int k = 0; k < 2; ++k) \
        acc[ai][bj][m][n] = __builtin_amdgcn_mfma_f32_16x16x32_bf16(Bt[n][k], At[m][k], acc[ai][bj][m][n], 0, 0, 0); __builtin_amdgcn_s_setprio(0); } while (0)
#define PG_WAIT_V(n) asm volatile("s_waitcnt vmcnt(" #n ")" ::: "memory")
#define PG_WAIT_L(n) asm volatile("s_waitcnt lgkmcnt(" #n ")" ::: "memory")
#define PG_BAR __builtin_amdgcn_s_barrier()
#define PG_SCHED __builtin_amdgcn_sched_barrier(0)
#define PG_CALC_VA(dst, u) do { _Pragma("unroll") for (int _h = 0; _h < 2; ++_h) _Pragma("unroll") for (int _i = 0; _i < 2; ++_i) { const int _row = _h * HALF + RA[_i]; \
        const int _src = Sched::GATHER ? S.a_row(u, _row) : _row; dst[_h][_i] = (unsigned)(_src * lda + CA[_i]) * 2u; } } while (0)
    Unit cur, nxt; int ui = 0;
    if (!S.next(0, cur)) return;
    f32x4 acc[2][2][4][2];
#pragma unroll
    for (int a = 0; a < 2; ++a)
#pragma unroll
        for (int b = 0; b < 2; ++b)
#pragma unroll
            for (int m = 0; m < 4; ++m)
#pragma unroll
                for (int n = 0; n < 2; ++n) acc[a][b][m][n] = (f32x4){0.f, 0.f, 0.f, 0.f};
    bf16x8 At[4][2], B0[2][2], B1[2][2];
    unsigned vA[2][2], nvA[2][2];
    PG_CALC_VA(vA, cur);
    const char* cA = S.a_base(cur); const char* cB = S.b_base(cur);
    PG_STAGE(PG_SB(0, 0), cB, vB[0]); PG_STAGE(PG_SA(0, 0), cA, vA[0]); PG_STAGE(PG_SB(0, 1), cB, vB[1]); PG_STAGE(PG_SA(0, 1), cA, vA[1]);
    if (wr == 1) PG_BAR;
    PG_WAIT_V(4); PG_BAR;
    PG_STAGE(PG_SB(1, 0), cB + kstep, vB[0]); PG_STAGE(PG_SA(1, 0), cA + kstep, vA[0]); PG_STAGE(PG_SB(1, 1), cB + kstep, vB[1]);
    PG_WAIT_V(6); PG_BAR;
    for (;;) {
        const bool has_next = S.next(ui + 1, nxt);
        const char* nA = has_next ? S.a_base(nxt) : cA; const char* nB = has_next ? S.b_base(nxt) : cB;
        if (Sched::GATHER) { if (has_next) { PG_CALC_VA(nvA, nxt); } else {
#pragma unroll
            for (int h = 0; h < 2; ++h)
#pragma unroll
                for (int i = 0; i < 2; ++i) nvA[h][i] = vA[h][i]; } }
        else {
#pragma unroll
            for (int h = 0; h < 2; ++h)
#pragma unroll
                for (int i = 0; i < 2; ++i) nvA[h][i] = vA[h][i]; }
#pragma nounroll
        for (int t = 0; t < nt; t += 2) {
            const bool last = (t == nt - 2);
            const char* a1 = cA + (size_t)(t + 1) * kstep;
            const char* a2 = last ? nA : cA + (size_t)(t + 2) * kstep; const char* b2 = last ? nB : cB + (size_t)(t + 2) * kstep;
            const char* a3 = a2 + kstep; const char* b3 = b2 + kstep;
            unsigned sA[2][2];
#pragma unroll
            for (int h = 0; h < 2; ++h)
#pragma unroll
                for (int i = 0; i < 2; ++i) sA[h][i] = (Sched::GATHER && last) ? nvA[h][i] : vA[h][i];
            PG_LDB(B0, 0, 0); PG_SCHED; PG_LDA(At, 0, 0); PG_STAGE(PG_SA(1, 1), a1, vA[1]);
            PG_WAIT_L(8); PG_BAR; PG_WAIT_L(0); PG_MMA(0, 0, At, B0); PG_BAR; PG_SCHED;
            PG_LDB(B1, 0, 1); PG_STAGE(PG_SB(0, 0), b2, vB[0]);
            PG_BAR; PG_WAIT_L(0); PG_MMA(0, 1, At, B1); PG_BAR;
            PG_LDA(At, 0, 1); PG_STAGE(PG_SA(0, 0), a2, sA[0]);
            PG_BAR; PG_WAIT_L(0); PG_MMA(1, 0, At, B0); PG_BAR; PG_SCHED;
            PG_STAGE(PG_SB(0, 1), b2, vB[1]);
            PG_WAIT_V(6); PG_BAR; PG_MMA(1, 1, At, B1); PG_BAR;
            PG_LDB(B0, 1, 0); PG_SCHED; PG_LDA(At, 1, 0); PG_STAGE(PG_SA(0, 1), a2, sA[1]);
            PG_WAIT_L(8); PG_BAR; PG_WAIT_L(0); PG_MMA(0, 0, At, B0); PG_BAR; PG_SCHED;
            PG_LDB(B1, 1, 1); PG_STAGE(PG_SB(1, 0), b3, vB[0]);
            PG_BAR; PG_WAIT_L(0); PG_MMA(0, 1, At, B1); PG_BAR;
            PG_LDA(At, 1, 1); PG_STAGE(PG_SA(1, 0), a3, sA[0]);
            PG_BAR; PG_WAIT_L(0); PG_MMA(1, 0, At, B0); PG_BAR; PG_SCHED;
            PG_STAGE(PG_SB(1, 1), b3, vB[1]);
            PG_WAIT_V(6); PG_BAR; PG_MMA(1, 1, At, B1); PG_BAR;
        }
        E(acc, cur, wr, wc, fr, fq);
        if (!has_next) break;
#pragma unroll
        for (int a = 0; a < 2; ++a)
#pragma unroll
            for (int b = 0; b < 2; ++b)
#pragma unroll
                for (int m = 0; m < 4; ++m)
#pragma unroll
                    for (int n = 0; n < 2; ++n) acc[a][b][m][n] = (f32x4){0.f, 0.f, 0.f, 0.f};
        cur = nxt; cA = nA; cB = nB; ++ui;
#pragma unroll
        for (int h = 0; h < 2; ++h)
#pragma unroll
            for (int i = 0; i < 2; ++i) vA[h][i] = nvA[h][i];
    }
    PG_WAIT_V(0);
    if (wr == 0) PG_BAR;
    PG_BAR;
#undef PG_SA
#undef PG_SB
#undef PG_STAGE
#undef PG_LDA
#undef PG_LDB
#undef PG_MMA
#undef PG_WAIT_V
#undef PG_WAIT_L
#undef PG_BAR
#undef PG_SCHED
#undef PG_CALC_VA
}

struct DenseSched {
    static constexpr bool GATHER = false;
    const char* A; const char* Bt; size_t a_tile, b_tile; int nM, nN, nwg, G, c, rep;
    __device__ void init(const void* A_, const void* Bt_, int M, int N, int lda, int ldb, int G_, int c_) {
        rep = 1; A = (const char*)A_; Bt = (const char*)Bt_; a_tile = (size_t)BM * lda * 2; b_tile = (size_t)BM * ldb * 2; nM = M / BM; nN = N / BM; nwg = nM * nN; G = G_; c = c_; }
    __device__ __forceinline__ bool next(int i, Unit& u) const {
        const long L = (long)i * G + c; if (L >= (long)nwg * rep) return false;
        int wgid = (int)(L % nwg); { const int q = nwg / 8, r = nwg % 8, xcd = wgid % 8, off = wgid / 8; wgid = (xcd < r ? xcd * (q + 1) : r * (q + 1) + (xcd - r) * q) + off; }
        const int nig = 8 * nN, gid = wgid / nig, fm = gid * 8, gsz = (nM - fm) < 8 ? (nM - fm) : 8;
        u.pm = fm + ((wgid % nig) % gsz); u.pn = (wgid % nig) / gsz; u.g = 0; u.aux = 0; return true;
    }
    __device__ __forceinline__ const char* a_base(const Unit& u) const { return A + (size_t)u.pm * a_tile; }
    __device__ __forceinline__ const char* b_base(const Unit& u) const { return Bt + (size_t)u.pn * b_tile; }
    __device__ __forceinline__ int a_row(const Unit&, int r) const { return r; }
};
struct GroupSched {
    static constexpr bool GATHER = false;
    const char* A; const char* Bt; size_t a_tile, b_tile, a_gs, b_gs; int nM, nN, nwg, G, c, rep;
    __device__ void init(const void* A_, const void* Bt_, int NG, int Mg, int Ng, int lda, int ldb, size_t a_gstride, size_t b_gstride, int G_, int c_) {
        rep = 1; A = (const char*)A_; Bt = (const char*)Bt_; a_tile = (size_t)BM * lda * 2; b_tile = (size_t)BM * ldb * 2; a_gs = a_gstride; b_gs = b_gstride;
        nM = Mg / BM; nN = Ng / BM; nwg = NG * nM * nN; G = G_; c = c_; }
    __device__ __forceinline__ bool next(int i, Unit& u) const {
        const long L = (long)i * G + c; if (L >= (long)nwg * rep) return false;
        const int l = (int)(L % nwg); u.pn = l % nN; const int r = l / nN; u.pm = r % nM; u.g = r / nM; u.aux = 0; return true;
    }
    __device__ __forceinline__ const char* a_base(const Unit& u) const { return A + (size_t)u.g * a_gs + (size_t)u.pm * a_tile; }
    __device__ __forceinline__ const char* b_base(const Unit& u) const { return Bt + (size_t)u.g * b_gs + (size_t)u.pn * b_tile; }
    __device__ __forceinline__ int a_row(const Unit&, int r) const { return r; }
};
}

namespace ep {
using pg::Unit;
template <bool SRCF32>
struct Resid {
    static constexpr bool PERM = true;
    const void* src; bf16_t* dst_; int ld; bf16_t* dummy;
    __device__ __forceinline__ void operator()(const f32x4 (&acc)[2][2][4][2], const Unit& u, int wr, int wc, int fr, int fq) const {
        const int row0 = u.pm * 256 + wr * 64 + fr, col0 = u.pn * 256 + wc * 32 + 8 * fq; bf16_t* dst = u.aux ? dummy : dst_;
        if (SRCF32) { const float* sf = (const float*)src;
#pragma unroll
            for (int ai = 0; ai < 2; ++ai) { f32x4 b[4][2][2];
#pragma unroll
                for (int m = 0; m < 4; ++m) { const size_t off = (size_t)(row0 + ai * 128 + m * 16) * ld + col0;
#pragma unroll
                    for (int bj = 0; bj < 2; ++bj)
#pragma unroll
                        for (int n = 0; n < 2; ++n) b[m][bj][n] = *(const f32x4*)(sf + off + bj * 128 + n * 4); }
#pragma unroll
                for (int m = 0; m < 4; ++m) { const size_t off = (size_t)(row0 + ai * 128 + m * 16) * ld + col0;
#pragma unroll
                    for (int bj = 0; bj < 2; ++bj) { const f32x4 v0 = b[m][bj][0] + acc[ai][bj][m][0], v1 = b[m][bj][1] + acc[ai][bj][m][1];
                        u32x4 w; w.x = cvt_pk_bf16(v0[0], v0[1]); w.y = cvt_pk_bf16(v0[2], v0[3]); w.z = cvt_pk_bf16(v1[0], v1[1]); w.w = cvt_pk_bf16(v1[2], v1[3]);
                        *(u32x4*)(dst + off + bj * 128) = w; } } }
        } else { const bf16_t* sb = (const bf16_t*)src; u32x4 b[8][2];
#pragma unroll
            for (int q = 0; q < 8; ++q) { const size_t off = (size_t)(row0 + (q >> 2) * 128 + (q & 3) * 16) * ld + col0; b[q][0] = *(const u32x4*)(sb + off); b[q][1] = *(const u32x4*)(sb + off + 128); }
#pragma unroll
            for (int ai = 0; ai < 2; ++ai)
#pragma unroll
                for (int m = 0; m < 4; ++m) { const size_t off = (size_t)(row0 + ai * 128 + m * 16) * ld + col0;
#pragma unroll
                    for (int bj = 0; bj < 2; ++bj) { const u32x4 x = b[ai * 4 + m][bj]; const f32x4 a0 = acc[ai][bj][m][0], a1 = acc[ai][bj][m][1];
                        u32x4 w; w.x = cvt_pk_bf16(bflo(x.x) + a0[0], bfhi(x.x) + a0[1]); w.y = cvt_pk_bf16(bflo(x.y) + a0[2], bfhi(x.y) + a0[3]);
                        w.z = cvt_pk_bf16(bflo(x.z) + a1[0], bfhi(x.z) + a1[1]); w.w = cvt_pk_bf16(bflo(x.w) + a1[2], bfhi(x.w) + a1[3]);
                        *(u32x4*)(dst + off + bj * 128) = w; } }
        }
    }
};
struct LruIn {
    static constexpr bool PERM = true;
    bf16_t* gate; bf16_t* xrp; const float* rs;
    __device__ __forceinline__ void operator()(const f32x4 (&acc)[2][2][4][2], const Unit& u, int wr, int wc, int fr, int fq) const {
        const int row0 = u.pm * 256 + wr * 64 + fr; const bool isg = (u.pn < 8); const int col0 = (u.pn & 7) * 256 + wc * 32 + 8 * fq;
        bf16_t* base = isg ? gate : xrp; float rv[8];
#pragma unroll
        for (int q = 0; q < 8; ++q) rv[q] = rs[row0 + (q >> 2) * 128 + (q & 3) * 16];
#pragma unroll
        for (int ai = 0; ai < 2; ++ai)
#pragma unroll
            for (int m = 0; m < 4; ++m) { bf16_t* rowp = base + (size_t)(row0 + ai * 128 + m * 16) * 2048 + col0;
#pragma unroll
                for (int bj = 0; bj < 2; ++bj) { f32x4 v0 = acc[ai][bj][m][0] * rv[ai * 4 + m], v1 = acc[ai][bj][m][1] * rv[ai * 4 + m];
                    if (isg) { const f32x2 a = gelu_tanh_2(LO2(v0)), b = gelu_tanh_2(HI2(v0)), c = gelu_tanh_2(LO2(v1)), d = gelu_tanh_2(HI2(v1));
                        v0 = (f32x4){a[0], a[1], b[0], b[1]}; v1 = (f32x4){c[0], c[1], d[0], d[1]}; }
                    u32x4 w; w.x = cvt_pk_bf16(v0[0], v0[1]); w.y = cvt_pk_bf16(v0[2], v0[3]); w.z = cvt_pk_bf16(v1[0], v1[1]); w.w = cvt_pk_bf16(v1[2], v1[3]);
                    *(u32x4*)(rowp + bj * 128) = w; } }
    }
};
struct LruGates {
    static constexpr bool PERM = false;
    const bf16_t* xr; const float* b_a; const float* b_x; const float* spt; unsigned* LAB;
    __device__ __forceinline__ void operator()(const f32x4 (&acc)[2][2][4][2], const Unit& u, int wr, int wc, int fr, int fq) const {
        int fr_ = fr, fq_ = fq; asm volatile("" : "+v"(fr_), "+v"(fq_));
        const int dir = u.pn >> 1; const int row0 = u.pm * 256 + wr * 64 + fr_;
        const int ch0 = u.g * 256 + 128 * (u.pn & 1) + 16 * wc + 4 * fq_;
        f32x4 ba[2], bx[2], sp[2]; u32x2 xw[2][8];
#pragma unroll
        for (int bj = 0; bj < 2; ++bj) { const int ch = ch0 + 64 * bj; ba[bj] = *(const f32x4*)(b_a + dir * 2048 + ch); bx[bj] = *(const f32x4*)(b_x + dir * 2048 + ch); sp[bj] = *(const f32x4*)(spt + dir * 2048 + ch);
#pragma unroll
            for (int q = 0; q < 8; ++q) { const int t = row0 + (q >> 2) * 128 + (q & 3) * 16; xw[bj][q] = *(const u32x2*)((const char*)xr + (unsigned)((t * 2048 + ch) * 2)); } }
        constexpr float L2E = 1.4426950408889634f;
#pragma unroll
        for (int bj = 0; bj < 2; ++bj) { const int ch = ch0 + 64 * bj;
            f32x2 nba[2], nbx[2], m8[2], m8l[2];
#pragma unroll
            for (int p = 0; p < 2; ++p) { nba[p] = (f32x2){ba[bj][2 * p], ba[bj][2 * p + 1]} * (-L2E); nbx[p] = (f32x2){bx[bj][2 * p], bx[bj][2 * p + 1]} * (-L2E);
                m8[p] = (f32x2){sp[bj][2 * p], sp[bj][2 * p + 1]} * (-8.0f); m8l[p] = m8[p] * L2E; }
#pragma unroll
            for (int ai = 0; ai < 2; ++ai)
#pragma unroll
                for (int m = 0; m < 4; ++m) { const int t = row0 + ai * 128 + m * 16; const u32x2 x2 = xw[bj][ai * 4 + m];
                    u32x4 pk;
#pragma unroll
                    for (int p = 0; p < 2; ++p) { const unsigned xwd = p ? x2.y : x2.x; const f32x2 xv = (f32x2){bflo(xwd), bfhi(xwd)};
                        const f32x2 ar = (f32x2){acc[ai][bj][m][0][2 * p], acc[ai][bj][m][0][2 * p + 1]}, ax = (f32x2){acc[ai][bj][m][1][2 * p], acc[ai][bj][m][1][2 * p + 1]};
                        const f32x2 er = ar * (-L2E) + nba[p], ex = ax * (-L2E) + nbx[p];
                        const f32x2 dr = (f32x2){__builtin_amdgcn_exp2f(er[0]), __builtin_amdgcn_exp2f(er[1])} + 1.0f, dx = (f32x2){__builtin_amdgcn_exp2f(ex[0]), __builtin_amdgcn_exp2f(ex[1])} + 1.0f;
                        const f32x2 r = (f32x2){__builtin_amdgcn_rcpf(dr[0]), __builtin_amdgcn_rcpf(dr[1])}, ig = (f32x2){__builtin_amdgcn_rcpf(dx[0]), __builtin_amdgcn_rcpf(dx[1])};
                        const f32x2 la = r * m8[p], lal = r * m8l[p];
                        const f32x2 aa = (f32x2){__builtin_amdgcn_exp2f(lal[0]), __builtin_amdgcn_exp2f(lal[1])};
                        const f32x2 om = 1.0f - aa * aa;
                        const f32x2 bb = (f32x2){__builtin_amdgcn_sqrtf(om[0]), __builtin_amdgcn_sqrtf(om[1])} * (ig * xv);
                        pk[2 * p] = cvt_pk_bf16(la[0], bb[0]); pk[2 * p + 1] = cvt_pk_bf16(la[1], bb[1]); }
                    const unsigned ob = (unsigned)(((dir * S_ + t) * 2048 + ch) * 4);
                    *(u32x4*)((char*)LAB + ob) = pk; } }
    }
};
struct QkvRope {
    static constexpr bool PERM = false;
    bf16_t* o0; bf16_t* o1; bf16_t* o2; int c1, c2; const float* cs; const float* rs;
    __device__ __forceinline__ void operator()(const f32x4 (&acc)[2][2][4][2], const Unit& u, int wr, int wc, int fr, int fq) const {
        const int row0 = u.pm * 256 + wr * 64 + fr; const int ct = u.pn * 256;
        bf16_t* base; int cl; bool rope;
        if (ct < c1) { base = o0; cl = ct; rope = true; } else if (ct < c2) { base = o1; cl = ct - c1; rope = true; } else { base = o2; cl = ct - c2; rope = false; }
        rope = rope && (wc == 0);
        const int head0 = cl >> 7;
        f32x4 cva[8], sva[8];
#pragma unroll
        for (int q = 0; q < 8; ++q) { const int t = row0 + (q >> 2) * 128 + (q & 3) * 16; cva[q] = (f32x4){1.f, 1.f, 1.f, 1.f}; sva[q] = (f32x4){0.f, 0.f, 0.f, 0.f};
            if (rope) { cva[q] = *(const f32x4*)(cs + (size_t)t * 32 + 4 * fq); sva[q] = *(const f32x4*)(cs + (size_t)t * 32 + 16 + 4 * fq); }
            const float rv = rs[t]; cva[q] *= rv; sva[q] *= rv; }
#pragma unroll
        for (int ai = 0; ai < 2; ++ai)
#pragma unroll
            for (int m = 0; m < 4; ++m) { const int t = row0 + ai * 128 + m * 16; bf16_t* rowp = base + ((size_t)head0 * S_ + t) * 128 + wc * 32 + 4 * fq;
                const f32x4 cv = cva[ai * 4 + m], sv = sva[ai * 4 + m];
#pragma unroll
                for (int bj = 0; bj < 2; ++bj) { const f32x4 v0 = acc[ai][bj][m][0], v1 = acc[ai][bj][m][1];
                    const f32x4 r0 = v0 * cv - v1 * sv, r1 = v1 * cv + v0 * sv;
                    u32x2 w0, w1; w0.x = cvt_pk_bf16(r0[0], r0[1]); w0.y = cvt_pk_bf16(r0[2], r0[3]); w1.x = cvt_pk_bf16(r1[0], r1[1]); w1.y = cvt_pk_bf16(r1[2], r1[3]);
                    *(u32x2*)(rowp + (size_t)bj * S_ * 128) = w0; *(u32x2*)(rowp + (size_t)bj * S_ * 128 + 16) = w1; } }
    }
};
struct S5In {
    static constexpr bool PERM = false;
    float* U; bf16_t* UA; const float* rs;
    __device__ __forceinline__ void operator()(const f32x4 (&acc)[2][2][4][2], const Unit& u, int wr, int wc, int fr, int fq) const {
        const int row0 = u.pm * 256 + wr * 64 + fr, col0 = u.pn * 256 + wc * 32 + 4 * fq; float rv[8];
#pragma unroll
        for (int q = 0; q < 8; ++q) rv[q] = rs[row0 + (q >> 2) * 128 + (q & 3) * 16];
#pragma unroll
        for (int ai = 0; ai < 2; ++ai)
#pragma unroll
            for (int m = 0; m < 4; ++m) { const int t = row0 + ai * 128 + m * 16;
#pragma unroll
                for (int bj = 0; bj < 2; ++bj)
#pragma unroll
                    for (int n = 0; n < 2; ++n) { const int col = col0 + bj * 128 + n * 16; const f32x4 v = acc[ai][bj][m][n] * rv[ai * 4 + m];
                        *(f32x4*)(U + (size_t)t * 1024 + col) = v;
                        const int g = col >> 4, chn = col & 15; u32x2 w; w.x = cvt_pk_bf16(v[0], v[1]); w.y = cvt_pk_bf16(v[2], v[3]);
                        *(u32x2*)(UA + (size_t)g * (512 * 512) + (size_t)(t >> 4) * 512 + (t & 15) * 16 + chn) = w; } }
    }
};
struct F32Group {
    static constexpr bool PERM = false;
    float* C; int ld; size_t gstride;
    __device__ __forceinline__ void operator()(const f32x4 (&acc)[2][2][4][2], const Unit& u, int wr, int wc, int fr, int fq) const {
        const int row0 = u.pm * 256 + wr * 64 + fr, col0 = u.pn * 256 + wc * 32 + 4 * fq; float* Cg = C + (size_t)u.g * gstride;
#pragma unroll
        for (int ai = 0; ai < 2; ++ai)
#pragma unroll
            for (int m = 0; m < 4; ++m) { float* rowp = Cg + (size_t)(row0 + ai * 128 + m * 16) * ld + col0;
#pragma unroll
                for (int bj = 0; bj < 2; ++bj)
#pragma unroll
                    for (int n = 0; n < 2; ++n) *(f32x4*)(rowp + bj * 128 + n * 16) = acc[ai][bj][m][n]; }
    }
};
struct S5Y {
    static constexpr bool PERM = false;
    const float* U; const float* dsk; bf16_t* G;
    __device__ __forceinline__ void operator()(const f32x4 (&acc)[2][2][4][2], const Unit& u, int wr, int wc, int fr, int fq) const {
        const int row0 = u.pm * 256 + wr * 64 + fr; const int ch = 16 * u.g + 4 * fq;
        const f32x4 dv = *(const f32x4*)(dsk + ch);
#pragma unroll
        for (int ai = 0; ai < 2; ++ai) { f32x4 uv[4][2][2];
#pragma unroll
            for (int m = 0; m < 4; ++m) { const int c = row0 + ai * 128 + m * 16;
#pragma unroll
                for (int bj = 0; bj < 2; ++bj)
#pragma unroll
                    for (int n = 0; n < 2; ++n) { const int t = 16 * c + 8 * bj + 2 * wc + n; uv[m][bj][n] = *(const f32x4*)(U + (size_t)t * 1024 + ch); } }
#pragma unroll
            for (int m = 0; m < 4; ++m) { const int c = row0 + ai * 128 + m * 16;
#pragma unroll
                for (int bj = 0; bj < 2; ++bj)
#pragma unroll
                    for (int n = 0; n < 2; ++n) { const int t = 16 * c + 8 * bj + 2 * wc + n; const f32x4 y = acc[ai][bj][m][n] + dv * uv[m][bj][n];
                        const f32x2 ga = gelu_tanh_2(LO2(y)), gb = gelu_tanh_2(HI2(y));
                        u32x2 w; w.x = cvt_pk_bf16(ga[0], ga[1]); w.y = cvt_pk_bf16(gb[0], gb[1]);
                        *(u32x2*)(G + (size_t)t * 1024 + ch) = w; } } }
    }
};
struct S5Glu {
    static constexpr bool PERM = true;
    const bf16_t* G; bf16_t* Z;
    __device__ __forceinline__ void operator()(const f32x4 (&acc)[2][2][4][2], const Unit& u, int wr, int wc, int fr, int fq) const {
        const int row0 = u.pm * 256 + wr * 64 + fr, col0 = u.pn * 256 + wc * 32 + 8 * fq;
        u32x4 gwa[8][2];
#pragma unroll
        for (int q = 0; q < 8; ++q) { const size_t off = (size_t)(row0 + (q >> 2) * 128 + (q & 3) * 16) * 1024 + col0; gwa[q][0] = *(const u32x4*)(G + off); gwa[q][1] = *(const u32x4*)(G + off + 128); }
#pragma unroll
        for (int ai = 0; ai < 2; ++ai)
#pragma unroll
            for (int m = 0; m < 4; ++m) { const size_t off = (size_t)(row0 + ai * 128 + m * 16) * 1024 + col0;
#pragma unroll
                for (int bj = 0; bj < 2; ++bj) { const f32x4 v0 = acc[ai][bj][m][0], v1 = acc[ai][bj][m][1];
                    const u32x4 gw = gwa[ai * 4 + m][bj];
                    const float g0 = bflo(gw.x), g1 = bfhi(gw.x), g2 = bflo(gw.y), g3 = bfhi(gw.y), g4 = bflo(gw.z), g5 = bfhi(gw.z), g6 = bflo(gw.w), g7 = bfhi(gw.w);
                    const f32x2 za = (f32x2){g0, g1} * sigmoid_2(LO2(v0)), zb = (f32x2){g2, g3} * sigmoid_2(HI2(v0)), zc = (f32x2){g4, g5} * sigmoid_2(LO2(v1)), zd = (f32x2){g6, g7} * sigmoid_2(HI2(v1));
                    u32x4 w; w.x = cvt_pk_bf16(za[0], za[1]); w.y = cvt_pk_bf16(zb[0], zb[1]); w.z = cvt_pk_bf16(zc[0], zc[1]); w.w = cvt_pk_bf16(zd[0], zd[1]);
                    *(u32x4*)(Z + off + bj * 128) = w; } }
    }
};
struct MoeGU {
    static constexpr bool PERM = false;
    bf16_t* hdn; const float* rsg; const LAS int* lc;
    __device__ __forceinline__ void operator()(const f32x4 (&acc)[2][2][4][2], const Unit& u, int wr, int wc, int fr, int fq) const {
        const int row0 = u.aux * 256 + wr * 64 + fr; const int j0 = 128 * u.pn + 16 * wc + 4 * fq; float rv[8];
        { const int cnt = lc[u.g], i0 = u.pm * 256 + wr * 64 + fr;
#pragma unroll
          for (int q = 0; q < 8; ++q) { const int idx = i0 + (q >> 2) * 128 + (q & 3) * 16; rv[q] = (idx < cnt) ? rsg[u.g * 8192 + idx] : 0.f; } }
#pragma unroll
        for (int ai = 0; ai < 2; ++ai)
#pragma unroll
            for (int m = 0; m < 4; ++m) { bf16_t* rowp = hdn + (size_t)(row0 + ai * 128 + m * 16) * 512 + j0;
#pragma unroll
                for (int bj = 0; bj < 2; ++bj) { const f32x4 g = acc[ai][bj][m][0] * rv[ai * 4 + m], up = acc[ai][bj][m][1] * rv[ai * 4 + m]; float h[4];
#pragma unroll
                    for (int j = 0; j < 4; ++j) h[j] = g[j] * sigmoidf_(g[j]) * up[j];
                    u32x2 w; w.x = cvt_pk_bf16(h[0], h[1]); w.y = cvt_pk_bf16(h[2], h[3]);
                    *(u32x2*)(rowp + bj * 64) = w; } }
    }
};
struct MoeDown {
    static constexpr bool PERM = true;
    bf16_t* ys;
    __device__ __forceinline__ void operator()(const f32x4 (&acc)[2][2][4][2], const Unit& u, int wr, int wc, int fr, int fq) const {
        const int row0 = u.aux * 256 + wr * 64 + fr, col0 = u.pn * 256 + wc * 32 + 8 * fq;
#pragma unroll
        for (int ai = 0; ai < 2; ++ai)
#pragma unroll
            for (int m = 0; m < 4; ++m) { bf16_t* rowp = ys + (size_t)(row0 + ai * 128 + m * 16) * 2048 + col0;
#pragma unroll
                for (int bj = 0; bj < 2; ++bj) { const f32x4 v0 = acc[ai][bj][m][0], v1 = acc[ai][bj][m][1];
                    u32x4 w; w.x = cvt_pk_bf16(v0[0], v0[1]); w.y = cvt_pk_bf16(v0[2], v0[3]); w.z = cvt_pk_bf16(v1[0], v1[1]); w.w = cvt_pk_bf16(v1[2], v1[3]);
                    *(u32x4*)(rowp + bj * 128) = w; } }
    }
};
}

namespace att {
constexpr int D = 128, NW = 8, QBLK = 32, KVBLK = 64;
constexpr float SCALE = 0.088388347648318440f;
constexpr float THR = 8.f;
constexpr int SHM_V = KVBLK * D * 2, SHM_K = KVBLK * D * 2, SHM_ATTN = 2 * SHM_V + 2 * SHM_K + NW * 64 * 4;
#define KSWZ(row, colB) ((row) * 256 + ((colB) ^ (((row) & 7) << 4)))
#define SBAR() __builtin_amdgcn_sched_barrier(0)
__device__ __forceinline__ int crow(int r, int hi) { return (r & 3) + 8 * (r >> 2) + 4 * hi; }
__device__ __forceinline__ void partialSM(f32x16& p0, f32x16& p1, float& m_reg, float& mn, float& alpha) {
    constexpr float C = SCALE * 1.4426950408889634f;
    float pmax = p0[0];
#pragma unroll
    for (int r = 1; r < 16; ++r) pmax = fmaxf(pmax, p0[r]);
#pragma unroll
    for (int r = 0; r < 16; ++r) pmax = fmaxf(pmax, p1[r]);
    { auto rr = __builtin_amdgcn_permlane32_swap(__float_as_uint(pmax), __float_as_uint(pmax), false, false);
      pmax = fmaxf(__uint_as_float(rr[0]), __uint_as_float(rr[1])); }
    if (__builtin_expect(__all(pmax - m_reg <= THR / SCALE), 1)) { mn = m_reg; alpha = 1.f; }
    else { mn = fmaxf(m_reg, pmax); alpha = __builtin_amdgcn_exp2f((m_reg - mn) * C); m_reg = mn; }
    const float mnC = -mn * C;
#pragma unroll
    for (int r = 0; r < 16; ++r) p0[r] = fmaf(p0[r], C, mnC);
#pragma unroll
    for (int r = 0; r < 16; ++r) p1[r] = fmaf(p1[r], C, mnC);
#pragma unroll
    for (int r = 0; r < 16; ++r) p0[r] = __builtin_amdgcn_exp2f(p0[r]);
}
__device__ __forceinline__ void finishSM(f32x16& p0, f32x16& p1, float alpha, float& l_reg, bf16x8& pa0, bf16x8& pa1, bf16x8& pa2, bf16x8& pa3) {
#pragma unroll
    for (int r = 0; r < 16; ++r) p1[r] = __builtin_amdgcn_exp2f(p1[r]);
    float ps = 0;
#pragma unroll
    for (int r = 0; r < 16; ++r) ps += p0[r];
#pragma unroll
    for (int r = 0; r < 16; ++r) ps += p1[r];
    { auto rr = __builtin_amdgcn_permlane32_swap(__float_as_uint(ps), __float_as_uint(ps), false, false);
      ps = __uint_as_float(rr[0]) + __uint_as_float(rr[1]); }
    l_reg = l_reg * alpha + ps;
#define PK4(P, BASE, OUT) do { unsigned a0 = cvt_pk_bf16(P[BASE + 0], P[BASE + 1]), a1 = cvt_pk_bf16(P[BASE + 2], P[BASE + 3]);   \
    unsigned b0 = cvt_pk_bf16(P[BASE + 4], P[BASE + 5]), b1 = cvt_pk_bf16(P[BASE + 6], P[BASE + 7]);                              \
    auto r0 = __builtin_amdgcn_permlane32_swap(a0, b0, false, false); auto r1 = __builtin_amdgcn_permlane32_swap(a1, b1, false, false); \
    u32x4 w = {r0[0], r1[0], r0[1], r1[1]}; OUT = *reinterpret_cast<bf16x8*>(&w); } while (0)
    PK4(p0, 0, pa0); PK4(p0, 8, pa1); PK4(p1, 0, pa2); PK4(p1, 8, pa3);
#undef PK4
}
__device__ __forceinline__ void qkt(f32x16& p0, f32x16& p1, const LAS char* Ks, const bf16x8* qr, int r32, int hi) {
    p0 = f32x16{}; p1 = f32x16{};
#pragma unroll
    for (int d0 = 0; d0 < 8; ++d0) { const int cb = (d0 * 16 + hi * 8) * 2;
        const bf16x8 b0 = *reinterpret_cast<const LAS bf16x8*>(Ks + KSWZ(r32, cb));
        const bf16x8 b1 = *reinterpret_cast<const LAS bf16x8*>(Ks + KSWZ(32 + r32, cb));
        p0 = __builtin_amdgcn_mfma_f32_32x32x16_bf16(b0, qr[d0], p0, 0, 0, 0);
        p1 = __builtin_amdgcn_mfma_f32_32x32x16_bf16(b1, qr[d0], p1, 0, 0, 0); }
}
__device__ __forceinline__ void qkt4(f32x16& p0, f32x16& p1, const LAS char* Ks, const bf16x8* qr, const int (&ka)[4]) {
    p0 = f32x16{}; p1 = f32x16{};
#pragma unroll
    for (int d0 = 0; d0 < 8; ++d0) { const LAS char* a = Ks + ka[d0 & 3] + (d0 >> 2) * 128;
        const bf16x8 b0 = *reinterpret_cast<const LAS bf16x8*>(a);
        const bf16x8 b1 = *reinterpret_cast<const LAS bf16x8*>(a + 8192);
        p0 = __builtin_amdgcn_mfma_f32_32x32x16_bf16(b0, qr[d0], p0, 0, 0, 0);
        p1 = __builtin_amdgcn_mfma_f32_32x32x16_bf16(b1, qr[d0], p1, 0, 0, 0); }
}
__device__ __forceinline__ void wmask(f32x16& p0, f32x16& p1, int dbase, int hi) {
#pragma unroll
    for (int r = 0; r < 16; ++r) { const int d0 = dbase + crow(r, hi), d1 = d0 + 32;
        p0[r] = (d0 >= -128 && d0 <= 128) ? p0[r] : -1e30f; p1[r] = (d1 >= -128 && d1 <= 128) ? p1[r] : -1e30f; }
}
__device__ __forceinline__ int v_st(int k, int c) { const int kk = (k & ~0xC) | ((k & 4) << 1) | ((k & 8) >> 1); return ((kk >> 3) * 4 + (c >> 5)) * 512 + ((kk & 7) * 32 + (c & 31)) * 2; }
__device__ __forceinline__ int v_rd_base(int lane) { return ((lane & 3) << 3) | (((lane >> 2) & 3) << 6) | (((lane >> 4) & 1) << 5) | (((lane >> 5) & 1) << 8); }
constexpr int v_rd_off(int d0, int ks, int half) { return d0 * 512 + ks * 4096 + half * 2048; }
template <int OFF> __device__ __forceinline__ s16x4 tr_read(int vb) {
    s16x4 r; asm volatile("ds_read_b64_tr_b16 %0, %1 offset:%2" : "=&v"(r) : "v"(vb), "i"(OFF) : "memory"); return r;
}
template <int D0> __device__ __forceinline__ void pv_one(f32x16& od, int vb, bf16x8 pa0, bf16x8 pa1, bf16x8 pa2, bf16x8 pa3) {
    const s16x4 l0 = tr_read<v_rd_off(D0, 0, 0)>(vb), h0 = tr_read<v_rd_off(D0, 0, 1)>(vb), l1 = tr_read<v_rd_off(D0, 1, 0)>(vb), h1 = tr_read<v_rd_off(D0, 1, 1)>(vb);
    const s16x4 l2 = tr_read<v_rd_off(D0, 2, 0)>(vb), h2 = tr_read<v_rd_off(D0, 2, 1)>(vb), l3 = tr_read<v_rd_off(D0, 3, 0)>(vb), h3 = tr_read<v_rd_off(D0, 3, 1)>(vb);
    asm volatile("s_waitcnt lgkmcnt(0)" ::: "memory"); SBAR();
#define PK(L, H) (bf16x8){L[0], L[1], L[2], L[3], H[0], H[1], H[2], H[3]}
    od = __builtin_amdgcn_mfma_f32_32x32x16_bf16(pa0, PK(l0, h0), od, 0, 0, 0);
    od = __builtin_amdgcn_mfma_f32_32x32x16_bf16(pa1, PK(l1, h1), od, 0, 0, 0);
    od = __builtin_amdgcn_mfma_f32_32x32x16_bf16(pa2, PK(l2, h2), od, 0, 0, 0);
    od = __builtin_amdgcn_mfma_f32_32x32x16_bf16(pa3, PK(l3, h3), od, 0, 0, 0);
#undef PK
}
__device__ __forceinline__ void pv_d0(f32x16* o, int vb, bf16x8 pa0, bf16x8 pa1, bf16x8 pa2, bf16x8 pa3) {
    pv_one<0>(o[0], vb, pa0, pa1, pa2, pa3); pv_one<1>(o[1], vb, pa0, pa1, pa2, pa3); pv_one<2>(o[2], vb, pa0, pa1, pa2, pa3); pv_one<3>(o[3], vb, pa0, pa1, pa2, pa3);
}
template <int LDQ, int LDK, int LDV, int LDO, bool MASK, int NTC>
__device__ __forceinline__ void body(const bf16_t* __restrict__ Qb, const bf16_t* __restrict__ Kh, const bf16_t* __restrict__ Vh, bf16_t* __restrict__ Ob, const int NTR,
                                     LAS char* lds, const int qpos0, const int kpos0, const float sink_raw, const int tid_in) {
    int tid_ = tid_in; asm volatile("" : "+v"(tid_));
    const int tid = tid_, wid = tid >> 6, lane = tid & 63, r32 = lane & 31, hi = lane >> 5; const int NT = NTC ? NTC : NTR;
    LAS char* V_lds = lds; LAS char* K_lds = lds + 2 * SHM_V;
    LAS float* ws = (LAS float*)(lds + 2 * SHM_V + 2 * SHM_K) + wid * 64; LAS float* li_l = ws; LAS float* al_l = ws + 32;
    float m_reg = MASK ? sink_raw : -1e30f, l_reg = MASK ? 1.f : 0.f; f32x16 o[4] = {}; bf16x8 qr[8];
    const bf16_t* Qw = Qb + (long)(wid * QBLK + r32) * LDQ + hi * 8;
#pragma unroll
    for (int d0 = 0; d0 < 8; ++d0) qr[d0] = *reinterpret_cast<const bf16x8*>(Qw + d0 * 16);
    const int sr = tid >> 4, sc = (tid & 15) * 8, vst0 = v_st(sr, sc), vst1 = v_st(32 + sr, sc);
    const int vb0 = (int)(uintptr_t)V_lds + v_rd_base(lane);
    const int dq = kpos0 - (qpos0 + wid * QBLK + r32);
    struct { bf16x8 vs0, vs1, ks0, ks1; } sr_[2];
#define SLOAD(i, k0) do { sr_[i].vs0 = *reinterpret_cast<const bf16x8*>(&Vh[(long)((k0) + sr) * LDV + sc]); sr_[i].vs1 = *reinterpret_cast<const bf16x8*>(&Vh[(long)((k0) + 32 + sr) * LDV + sc]); \
    sr_[i].ks0 = *reinterpret_cast<const bf16x8*>(&Kh[(long)((k0) + sr) * LDK + sc]); sr_[i].ks1 = *reinterpret_cast<const bf16x8*>(&Kh[(long)((k0) + 32 + sr) * LDK + sc]); } while (0)
#define SWRITE(b, i) do { *(LAS bf16x8*)(V_lds + (b) * SHM_V + vst0) = sr_[i].vs0;          \
    *(LAS bf16x8*)(V_lds + (b) * SHM_V + vst1) = sr_[i].vs1; const int kc = sc * 2;               \
    *(LAS bf16x8*)(K_lds + (b) * SHM_K + KSWZ(sr, kc)) = sr_[i].ks0;                       \
    *(LAS bf16x8*)(K_lds + (b) * SHM_K + KSWZ(32 + sr, kc)) = sr_[i].ks1; } while (0)
#define SWAIT() asm volatile("s_waitcnt vmcnt(4)" ::: "memory")
#define RESC(a) do { if (__any((a) < 1.f)) { if (hi == 0) al_l[r32] = (a); asm volatile("s_waitcnt lgkmcnt(0)" ::: "memory"); \
    _Pragma("unroll") for (int d = 0; d < 4; ++d) _Pragma("unroll") for (int r = 0; r < 16; ++r) o[d][r] *= al_l[crow(r, hi)]; } } while (0)
    f32x16 pA0, pA1, pB0, pB1; float mnA, mnB, alA, alB; bf16x8 pa0, pa1, pa2, pa3;
    constexpr int SE = 0, SO = 1;
    SLOAD(SE, 0); asm volatile("s_waitcnt vmcnt(0)" ::: "memory"); SWRITE(0, SE); __syncthreads();
    qkt(pA0, pA1, K_lds, qr, r32, hi); if (MASK) wmask(pA0, pA1, dq, hi); partialSM(pA0, pA1, m_reg, mnA, alA);
    SLOAD(SO, KVBLK); if (2 < NT) SLOAD(SE, 2 * KVBLK);
    SWAIT(); SWRITE(1, SO); __syncthreads();
    for (int j = 1; j + 1 < NT; j += 2) {
        SBAR(); qkt(pB0, pB1, K_lds + SHM_K, qr, r32, hi); if (MASK) wmask(pB0, pB1, dq + j * KVBLK, hi);
        finishSM(pA0, pA1, alA, l_reg, pa0, pa1, pa2, pa3); SBAR();
        SLOAD(SO, (j + 2) * KVBLK); SBAR();
        pv_d0(o, vb0, pa0, pa1, pa2, pa3); partialSM(pB0, pB1, m_reg, mnB, alB);
        __syncthreads(); SWAIT(); SWRITE(0, SE);
        RESC(alB); __syncthreads();
        SBAR(); qkt(pA0, pA1, K_lds, qr, r32, hi); if (MASK) wmask(pA0, pA1, dq + (j + 1) * KVBLK, hi);
        finishSM(pB0, pB1, alB, l_reg, pa0, pa1, pa2, pa3); SBAR();
        if (j + 3 < NT) SLOAD(SE, (j + 3) * KVBLK); SBAR();
        pv_d0(o, vb0 + SHM_V, pa0, pa1, pa2, pa3); partialSM(pA0, pA1, m_reg, mnA, alA);
        __syncthreads(); SWAIT(); SWRITE(1, SO);
        RESC(alA); __syncthreads();
    }
    SBAR(); qkt(pB0, pB1, K_lds + SHM_K, qr, r32, hi); if (MASK) wmask(pB0, pB1, dq + (NT - 1) * KVBLK, hi);
    finishSM(pA0, pA1, alA, l_reg, pa0, pa1, pa2, pa3); SBAR();
    pv_d0(o, vb0, pa0, pa1, pa2, pa3); partialSM(pB0, pB1, m_reg, mnB, alB);
    __syncthreads(); RESC(alB);
    finishSM(pB0, pB1, alB, l_reg, pa0, pa1, pa2, pa3); SBAR();
    pv_d0(o, vb0 + SHM_V, pa0, pa1, pa2, pa3);
    if (hi == 0) li_l[r32] = l_reg; asm volatile("s_waitcnt lgkmcnt(0)" ::: "memory");
    float rli[16];
#pragma unroll
    for (int r = 0; r < 16; ++r) rli[r] = __builtin_amdgcn_rcpf(li_l[crow(r, hi)]);
    bf16_t* Ow = Ob + (long)(wid * QBLK) * LDO;
#pragma unroll
    for (int r = 0; r < 16; ++r) { const int orow = crow(r, hi);
#pragma unroll
        for (int d0 = 0; d0 < 4; ++d0) Ow[(long)orow * LDO + d0 * 32 + r32] = f2bf(o[d0][r] * rli[r]); }
    __syncthreads();
#undef SLOAD
#undef SWRITE
#undef SWAIT
#undef RESC
}

template <int G> struct PvG { static constexpr int vh = G >> 2, d0 = G & 3, base = vh * 16384 + d0 * 512; };
#define PVG_RD(G, X) do { X##0 = tr_read<PvG<G>::base>(vb); X##1 = tr_read<PvG<G>::base + 2048>(vb); X##2 = tr_read<PvG<G>::base + 4096>(vb); X##3 = tr_read<PvG<G>::base + 6144>(vb); \
    X##4 = tr_read<PvG<G>::base + 8192>(vb); X##5 = tr_read<PvG<G>::base + 10240>(vb); X##6 = tr_read<PvG<G>::base + 12288>(vb); X##7 = tr_read<PvG<G>::base + 14336>(vb); } while (0)
#define PVG_PK(L, H) (bf16x8){L[0], L[1], L[2], L[3], H[0], H[1], H[2], H[3]}
#define PVG_MM(G, X) do { o[G] = __builtin_amdgcn_mfma_f32_32x32x16_bf16(pa0, PVG_PK(X##0, X##1), o[G], 0, 0, 0); o[G] = __builtin_amdgcn_mfma_f32_32x32x16_bf16(pa1, PVG_PK(X##2, X##3), o[G], 0, 0, 0); \
    o[G] = __builtin_amdgcn_mfma_f32_32x32x16_bf16(pa2, PVG_PK(X##4, X##5), o[G], 0, 0, 0); o[G] = __builtin_amdgcn_mfma_f32_32x32x16_bf16(pa3, PVG_PK(X##6, X##7), o[G], 0, 0, 0); } while (0)
#define PVG_W8() do { asm volatile("s_waitcnt lgkmcnt(8)" ::: "memory"); SBAR(); } while (0)
__device__ __forceinline__ void pv_pipe8(f32x16 (&o)[8], const int vb, const bf16x8 pa0, const bf16x8 pa1, const bf16x8 pa2, const bf16x8 pa3) {
    s16x4 a0, a1, a2, a3, a4, a5, a6, a7, b0, b1, b2, b3, b4, b5, b6, b7;
    PVG_RD(0, a);
    PVG_RD(1, b); PVG_W8(); PVG_MM(0, a);
    PVG_RD(2, a); PVG_W8(); PVG_MM(1, b);
    PVG_RD(3, b); PVG_W8(); PVG_MM(2, a);
    PVG_RD(4, a); PVG_W8(); PVG_MM(3, b);
    PVG_RD(5, b); PVG_W8(); PVG_MM(4, a);
    PVG_RD(6, a); PVG_W8(); PVG_MM(5, b);
    PVG_RD(7, b); PVG_W8(); PVG_MM(6, a);
    asm volatile("s_waitcnt lgkmcnt(0)" ::: "memory"); SBAR(); PVG_MM(7, b);
}
#undef PVG_RD
#undef PVG_PK
#undef PVG_MM
#undef PVG_W8

constexpr int B2_V = 0, B2_K = 65536, B2_WS = 98304, B2_LAM = B2_WS + NW * 256, SHM_ATTN2 = B2_LAM + 16;
template <int LDQ, int LDK, int LDV, int LDO, int EPI>
__device__ __forceinline__ void body2(const bf16_t* __restrict__ Qb, const bf16_t* __restrict__ Kh, const bf16_t* __restrict__ Vlo, const bf16_t* __restrict__ Vhi,
                                      bf16_t* __restrict__ Ob, const int NT, LAS char* lds, const int tid_in, float* __restrict__ Oscr, const float lam, const float* __restrict__ gsub, const float post) {
    int tid_ = tid_in; asm volatile("" : "+v"(tid_));
    const int tid = tid_, wid = __builtin_amdgcn_readfirstlane(tid >> 6), lane = tid & 63, r32 = lane & 31, hi = lane >> 5; const bool halfA = wid < 4;
    LAS float* ws = (LAS float*)(lds + B2_WS) + wid * 64; LAS float* li_l = ws; LAS float* al_l = ws + 32;
    float m_reg = -1e30f, l_reg = 0.f; f32x16 o[8] = {}; bf16x8 qr[8];
    const bf16_t* Qw = Qb + (long)(wid * QBLK + r32) * LDQ + hi * 8;
#pragma unroll
    for (int d0 = 0; d0 < 8; ++d0) qr[d0] = *reinterpret_cast<const bf16x8*>(Qw + d0 * 16);
    const int vbase = (int)(uintptr_t)(lds + B2_V) + v_rd_base(lane);
    int ka[4];
#pragma unroll
    for (int d = 0; d < 4; ++d) ka[d] = r32 * 256 + ((d * 32 + hi * 16) ^ ((r32 & 7) << 4));
    unsigned kof[2], vof[2];
#pragma unroll
    for (int i = 0; i < 2; ++i) { const int n = wid * 128 + i * 64 + lane;
        { const int row = n >> 4, ch = (n & 15) ^ (row & 7); kof[i] = (unsigned)(row * (LDK * 2) + ch * 16); }
        { const int st = n >> 5, wi = n & 31, kk = (st >> 2) * 8 + (wi >> 2), k = (kk & ~0xC) | ((kk & 4) << 1) | ((kk & 8) >> 1), c = (st & 3) * 32 + (wi & 3) * 8; vof[i] = (unsigned)(k * (LDV * 2) + c * 2); } }
    const unsigned ldsw = (unsigned)wid * 2048u;
#define GLDS(gp, lp) __builtin_amdgcn_global_load_lds((const unsigned*)(gp), (LAS unsigned*)(lp), 16, 0, 0)
#define DMA(j_, b_) do { const char* kt_ = (const char*)Kh + (size_t)(j_) * (KVBLK * LDK * 2); const char* vl_ = (const char*)Vlo + (size_t)(j_) * (KVBLK * LDV * 2); const char* vh_ = (const char*)Vhi + (size_t)(j_) * (KVBLK * LDV * 2); \
    _Pragma("unroll") for (int i_ = 0; i_ < 2; ++i_) { GLDS(kt_ + kof[i_], lds + B2_K + (b_) * 16384 + ldsw + i_ * 1024); \
        GLDS(vl_ + vof[i_], lds + B2_V + (b_) * 32768 + ldsw + i_ * 1024); GLDS(vh_ + vof[i_], lds + B2_V + (b_) * 32768 + 16384 + ldsw + i_ * 1024); } } while (0)
    f32x16 p0, p1; float mn, al; bf16x8 pa0, pa1, pa2, pa3;
#define PH_X(kb) do { qkt4(p0, p1, lds + B2_K + (kb) * 16384, qr, ka); partialSM(p0, p1, m_reg, mn, al); finishSM(p0, p1, al, l_reg, pa0, pa1, pa2, pa3); \
    if (__any(al < 1.f)) { if (hi == 0) al_l[r32] = al; asm volatile("s_waitcnt lgkmcnt(0)" ::: "memory"); \
        _Pragma("unroll") for (int d = 0; d < 8; ++d) _Pragma("unroll") for (int r = 0; r < 16; ++r) o[d][r] *= al_l[crow(r, hi)]; } } while (0)
#define PH_Y(vb) do { pv_pipe8(o, vbase + (vb) * 32768, pa0, pa1, pa2, pa3); } while (0)
    DMA(0, 0);
    asm volatile("s_waitcnt vmcnt(0)" ::: "memory"); __syncthreads();
#pragma nounroll
    for (int j = 0; j < NT; ++j) {
        if (j + 1 < NT) DMA(j + 1, (j + 1) & 1);
        PH_X(j & 1);
        PH_Y(j & 1);
        asm volatile("s_waitcnt vmcnt(0)" ::: "memory"); __syncthreads();
    }
    { int l2; asm volatile("v_mbcnt_lo_u32_b32 %0, -1, 0\n\tv_mbcnt_hi_u32_b32 %0, -1, %0" : "=v"(l2));
      const int r32e = l2 & 31, hie = l2 >> 5;
      if (hie == 0) li_l[r32e] = l_reg; asm volatile("s_waitcnt lgkmcnt(0)" ::: "memory");
      float rli[16];
#pragma unroll
      for (int r = 0; r < 16; ++r) rli[r] = __builtin_amdgcn_rcpf(li_l[crow(r, hie)]);
      if (EPI == 0) {
          bf16_t* Ow = Ob + (long)(wid * QBLK) * LDO;
#pragma unroll
          for (int r = 0; r < 16; ++r) { const int orow = crow(r, hie);
#pragma unroll
              for (int d0 = 0; d0 < 8; ++d0) Ow[(long)orow * LDO + d0 * 32 + r32e] = f2bf(o[d0][r] * rli[r]); }
      } else if (EPI == 1) {
          float* sc = Oscr + (wid * 64 + l2);
#pragma unroll
          for (int d0 = 0; d0 < 8; ++d0)
#pragma unroll
              for (int r = 0; r < 16; ++r) sc[(d0 * 16 + r) * 512] = o[d0][r] * rli[r];
      } else {
          const float lam_ = ((const LAS float*)(lds + B2_LAM))[0];
          const float* sc = Oscr + (wid * 64 + l2); float gs[8];
#pragma unroll
          for (int d0 = 0; d0 < 8; ++d0) gs[d0] = gsub[d0 * 32 + r32e] * post;
          bf16_t* Ow = Ob + (long)(wid * QBLK) * LDO;
#pragma unroll
          for (int rg = 0; rg < 4; ++rg) { float c4[4][8];
#pragma unroll
              for (int q = 0; q < 4; ++q)
#pragma unroll
                  for (int d0 = 0; d0 < 8; ++d0) c4[q][d0] = sc[(d0 * 16 + rg * 4 + q) * 512];
              asm volatile("" ::: "memory");
#pragma unroll
              for (int q = 0; q < 4; ++q) { const int r = rg * 4 + q; float ss = 0.f;
#pragma unroll
                  for (int d0 = 0; d0 < 8; ++d0) { c4[q][d0] -= lam_ * (o[d0][r] * rli[r]); ss += c4[q][d0] * c4[q][d0]; }
                  ss += __shfl_xor(ss, 1); ss += __shfl_xor(ss, 2); ss += __shfl_xor(ss, 4); ss += __shfl_xor(ss, 8); ss += __shfl_xor(ss, 16);
                  const float rs = rsqrtf(ss * (1.0f / 256.0f) + NORM_EPS); const int orow = crow(r, hie);
#pragma unroll
                  for (int d0 = 0; d0 < 8; ++d0) Ow[(long)orow * LDO + d0 * 32 + r32e] = f2bf(c4[q][d0] * rs * gs[d0]); } }
      } }
    asm volatile("s_waitcnt vmcnt(0)" ::: "memory");
    __syncthreads();
#undef GLDS
#undef DMA
#undef PH_X
#undef PH_Y
}
}

constexpr size_t al256(size_t x) { return (x + 255) / 256 * 256; }
constexpr size_t WS_CTL      = 0;
constexpr size_t CTL_BAR     = 0;
constexpr size_t CTL_CNT     = 16384;
constexpr size_t CTL_BYTES   = 32768;
constexpr size_t WS_W_LRU_IN = WS_CTL + CTL_BYTES;
constexpr size_t WS_W_LRU_G  = WS_W_LRU_IN + (size_t)4096 * 2048 * 2;
constexpr size_t WS_W_LRU_O  = WS_W_LRU_G + (size_t)8 * 1024 * 256 * 2;
constexpr size_t WS_W_DF_QKV = WS_W_LRU_O + (size_t)2048 * 2048 * 2;
constexpr size_t WS_W_DF_O   = WS_W_DF_QKV + (size_t)6144 * 2048 * 2;
constexpr size_t WS_W_WN_QKV = WS_W_DF_O + (size_t)2048 * 2048 * 2;
constexpr size_t WS_W_WN_O   = WS_W_WN_QKV + (size_t)3072 * 2048 * 2;
constexpr size_t WS_W_S5_IN  = WS_W_WN_O + (size_t)2048 * 2048 * 2;
constexpr size_t WS_W_S5_GLU = WS_W_S5_IN + (size_t)1024 * 2048 * 2;
constexpr size_t WS_W_S5_O   = WS_W_S5_GLU + (size_t)1024 * 1024 * 2;
constexpr size_t WS_S5_E     = WS_W_S5_O + (size_t)2048 * 1024 * 2;
constexpr size_t WS_S5_TF    = WS_S5_E + (size_t)64 * 256 * 256 * 2;
constexpr size_t WS_S5_LAM   = WS_S5_TF + (size_t)64 * 256 * 512 * 2;
constexpr size_t WS_ROPE     = WS_S5_LAM + (size_t)64 * 2 * 64 * 2 * 4;
constexpr size_t WS_SPT      = WS_ROPE + (size_t)S_ * 32 * 4;
constexpr size_t WS_WRT      = WS_SPT + (size_t)2 * 2048 * 4;
constexpr size_t WS_W_MOE    = WS_WRT + (size_t)4 * 36 * 2048 * 4;
constexpr size_t MOE_GU_B    = (size_t)1024 * 2048 * 2, MOE_DN_B = (size_t)2048 * 512 * 2, MOE_LE_B = MOE_GU_B + MOE_DN_B;
constexpr size_t WS_X        = WS_W_MOE + (size_t)128 * MOE_LE_B;
constexpr size_t WS_RS       = WS_X + (size_t)(S_ + 8) * 2048 * 2;
constexpr size_t WS_RSG      = WS_RS + (size_t)S_ * 4;
constexpr size_t WS_H        = WS_X + (size_t)S_ * 2048 * 4;
constexpr size_t WS_ROWTOK   = al256(WS_H + (size_t)(S_ + 1) * 2048 * 2);
constexpr size_t WS_TOPE     = WS_ROWTOK + (size_t)32 * 8192 * 4;
constexpr size_t WS_TOPW     = WS_TOPE + (size_t)S_ * 2 * 4;
constexpr size_t WS_SLOT     = WS_TOPW + (size_t)S_ * 2 * 4;
constexpr size_t WS_HDN      = WS_SLOT + (size_t)S_ * 2 * 4;
constexpr size_t WS_YS       = WS_HDN + (size_t)MAXTILES * 256 * 512 * 2;
constexpr size_t WS_ARENA    = WS_YS + (size_t)MAXTILES * 256 * 2048 * 2;
constexpr size_t AR_GATE = 0, AR_XRP = AR_GATE + (size_t)S_ * 2048 * 2, AR_XR = AR_XRP + (size_t)S_ * 2048 * 2, AR_YG = AR_XR + (size_t)S_ * 2048 * 2;
constexpr size_t AR_LAB = AR_YG + (size_t)S_ * 2048 * 2, AR_CHA = AR_LAB + (size_t)2 * S_ * 2048 * 4;
constexpr size_t AR_CHB = AR_CHA + (size_t)2 * NCH * 2048 * 4, AR_CAR = AR_CHB + (size_t)2 * NCH * 2048 * 4, AR_LRU_END = AR_CAR + (size_t)2 * NCH * 2048 * 4;
constexpr size_t AR_Q = 0, AR_K = AR_Q + (size_t)S_ * 2048 * 2, AR_V = AR_K + (size_t)S_ * 2048 * 2, AR_O = AR_V + (size_t)S_ * 2048 * 2, AR_OD = AR_O + (size_t)S_ * 4096 * 2;
constexpr size_t AR_ATT_END = AR_OD + (size_t)S_ * 2048 * 2;
constexpr size_t AR_U = 0, AR_UA = AR_U + (size_t)S_ * 1024 * 4, AR_SL = AR_UA + (size_t)64 * 512 * 512 * 2, AR_G = AR_SL + (size_t)64 * 512 * 256 * 4;
constexpr size_t AR_Z = AR_G + (size_t)S_ * 1024 * 2, AR_S5_END = AR_Z + (size_t)S_ * 1024 * 2;
constexpr size_t WS_END = WS_ARENA + (AR_LRU_END > AR_ATT_END ? (AR_LRU_END > AR_S5_END ? AR_LRU_END : AR_S5_END) : (AR_ATT_END > AR_S5_END ? AR_ATT_END : AR_S5_END));

constexpr int LDS_BYTES = 147456;
constexpr int LDS_MISC = 131072;
constexpr int LDS_TLE = LDS_MISC + 64;
constexpr int LDS_TLI = LDS_TLE + MAXTILES * 4;
constexpr int LDS_CNT = LDS_TLI + MAXTILES * 4;
constexpr int LDS_TB  = LDS_CNT + 32 * 4;
constexpr int LDS_NT  = LDS_TB + 36 * 4;

struct DenseW { const float* src; bf16_t* dst; int K, N; const float* gain; };
struct Args {
    const float* in[40];
    float* out; unsigned char* ws;
    DenseW dw[10];
    int ph_lo, ph_hi, grid, pad;
};

enum { I_X = 0, I_POS, I_LN_MIX, I_LN_FFN, I_LN_FINAL, I_LRU_W_IN, I_LRU_CONV_W, I_LRU_CONV_B, I_LRU_W_A, I_LRU_W_X, I_LRU_B_A, I_LRU_B_X, I_LRU_LAMBDA, I_LRU_W_OUT,
       I_DIFF_W_QKV, I_DIFF_LQ1, I_DIFF_LK1, I_DIFF_LQ2, I_DIFF_LK2, I_DIFF_SUBLN, I_DIFF_W_OUT, I_WIN_W_QKV, I_WIN_SINK, I_WIN_W_OUT,
       I_S5_W_IN, I_S5_A_RE, I_S5_A_IM, I_S5_LOG_DT, I_S5_B_RE, I_S5_B_IM, I_S5_C_RE, I_S5_C_IM, I_S5_D, I_S5_W_GLU, I_S5_W_OUT,
       I_MOE_W_GROUP, I_MOE_W_EXPERT, I_MOE_W_GATE, I_MOE_W_UP, I_MOE_W_DOWN, N_INPUTS };

typedef const Args __attribute__((address_space(4))) CArgs;
__device__ __forceinline__ CArgs* kargs() { CArgs* p = (CArgs*)__builtin_amdgcn_kernarg_segment_ptr(); asm volatile("" : "+s"(p)); return p; }
__device__ __forceinline__ int lane_id_opaque() { int l; asm volatile("v_mbcnt_lo_u32_b32 %0, -1, 0\n\tv_mbcnt_hi_u32_b32 %0, -1, %0" : "=v"(l)); return l; }
#define TID() (wave_s * 64 + lane_id_opaque())
#define GRID_N ((int)kargs()->grid)
#define BLOCK_ID ((int)__builtin_amdgcn_workgroup_id_x())

__device__ const double ROPE_INV[16] = {1.0, 0.44036660267178046, 0.19392274474868576, 0.08539710028576561, 0.03760603093086393, 0.016560440080994446, 0.007292664737217109, 0.003211445994752591, 0.001414213562373095, 0.000622772421914596, 0.0002742481756762073, 0.00012076973741146504, 5.318295896944988e-05, 2.341999896140934e-05, 1.031338537721246e-05, 4.5416704806078695e-06};

__device__ __forceinline__ void sincos_d(double x, float& sn, float& cs) {
    const double k = rint(x * 0.15915494309189535); const double r = x - k * 6.283185307179586, r2 = r * r;
    double s = r, ts = r, c = 1.0, tc = 1.0;
#pragma unroll
    for (int n = 1; n <= 13; ++n) { ts *= -r2 / (double)((2 * n) * (2 * n + 1)); s += ts; tc *= -r2 / (double)((2 * n - 1) * (2 * n)); c += tc; }
    sn = (float)s; cs = (float)c;
}

template <class F>
__device__ __forceinline__ void convT_load(float (&v)[16], const F& f, int n0, int k0, int tid) {
    const int nn = tid & 127, kq = tid >> 7; const float* cp = f.colptr(n0 + nn) + (size_t)(k0 + kq) * f.ld;
#pragma unroll
    for (int it = 0; it < 16; ++it) v[it] = __builtin_nontemporal_load(cp + (size_t)(4 * it) * f.ld);
}
__device__ __forceinline__ void convT_put(LAS float* tile, const float (&v)[16], int tid) {
    const int nn = tid & 127, kq = tid >> 7;
#pragma unroll
    for (int it = 0; it < 16; ++it) tile[nn * 65 + kq + 4 * it] = v[it];
}
__device__ __forceinline__ void convT_gain(const float* gain, int k0, int tid, f32x4& g0, f32x4& g1) {
    g0 = (f32x4){1.f, 1.f, 1.f, 1.f}; g1 = g0; if (gain) { g0 = *(const f32x4*)(gain + k0 + (tid & 7) * 8); g1 = *(const f32x4*)(gain + k0 + (tid & 7) * 8 + 4); }
}
__device__ __forceinline__ void convT_store(const LAS float* tile, bf16_t* dst, int K, int n0, int k0, int tid, const f32x4 g0, const f32x4 g1) {
#pragma unroll
    for (int r = 0; r < 2; ++r) { const int q = tid + 512 * r, nn = q >> 3, kc = q & 7; const LAS float* tp = tile + nn * 65 + kc * 8;
        u32x4 w; w.x = cvt_pk_bf16(tp[0] * g0[0], tp[1] * g0[1]); w.y = cvt_pk_bf16(tp[2] * g0[2], tp[3] * g0[3]); w.z = cvt_pk_bf16(tp[4] * g1[0], tp[5] * g1[1]); w.w = cvt_pk_bf16(tp[6] * g1[2], tp[7] * g1[3]);
        __builtin_nontemporal_store(w, (u32x4*)(dst + (size_t)(n0 + nn) * K + k0 + kc * 8)); }
}
struct ColPlain { const float* src; bf16_t* dst; int ld, K; const float* gain; __device__ __forceinline__ const float* colptr(int n) const { return src + n; } };
struct ColGU { const float* wg; long long du; bf16_t* dst; int ld, K; const float* gain;
    __device__ __forceinline__ const float* colptr(int c) const { const int j = (c >> 5) * 16 + (c & 15); return (const float*)((const char*)wg + ((c & 16) ? du : 0ll)) + j; } };


constexpr int MOE_L0_TILES = 32 * 384, MOE_ALL_TILES = 128 * 384;
constexpr size_t CTL_CURSOR = 24576;
constexpr size_t CTL_CURSOR0 = 24576 + 2048;
constexpr int LDS_GRAB = 131072 + 32;
constexpr int MOE_LAYER_TILES = 32 * 384, MOE_GU_TILES = 32 * 256;
__device__ __forceinline__ void moe_tile_decode(int t, int& le, int& r) {
    const int layer = t / MOE_LAYER_TILES, q = t % MOE_LAYER_TILES;
    if (q < MOE_GU_TILES) { le = layer * 32 + (q >> 8); r = q & 255; } else { const int q2 = q - MOE_GU_TILES; le = layer * 32 + (q2 >> 7); r = 256 + (q2 & 127); }
}
__device__ __forceinline__ void moe_tile_load(CArgs* ap, float (&v)[16], f32x4& g0, f32x4& g1, int t, int tid) {
    const float* wgate = ap->in[I_MOE_W_GATE]; const float* wup = ap->in[I_MOE_W_UP]; const float* wdn = ap->in[I_MOE_W_DOWN];
    int le, r; moe_tile_decode(t, le, r);
    if (r < 256) { ColGU f{wgate + (size_t)le * 2048 * 512, (long long)((const char*)wup - (const char*)wgate), nullptr, 512, 2048, nullptr}; convT_load(v, f, (r / 32) * 128, (r % 32) * 64, tid); convT_gain(ap->in[I_LN_FFN] + (le >> 5) * 2048, (r % 32) * 64, tid, g0, g1); }
    else { const int q = r - 256; ColPlain f{wdn + (size_t)le * 512 * 2048, nullptr, 2048, 512, nullptr}; convT_load(v, f, (q / 8) * 128, (q % 8) * 64, tid); convT_gain(nullptr, 0, tid, g0, g1); }
}
__device__ __forceinline__ void moe_tile_store(CArgs* ap, const LAS float* tile, int t, int tid, const f32x4 g0, const f32x4 g1) {
    int le, r; moe_tile_decode(t, le, r); bf16_t* base = (bf16_t*)(ap->ws + WS_W_MOE + (size_t)le * MOE_LE_B);
    if (r < 256) convT_store(tile, base, 2048, (r / 32) * 128, (r % 32) * 64, tid, g0, g1);
    else { const int q = r - 256; convT_store(tile, base + (size_t)1024 * 2048, 512, (q / 8) * 128, (q % 8) * 64, tid, g0, g1); }
}
constexpr int ND_TILES = 5504;
constexpr int LDS_DW = LDS_NT + 16;
__device__ __forceinline__ void dense_desc_build(CArgs* ap, LAS unsigned char* lds, int tid) {
    LAS int* d = (LAS int*)(lds + LDS_DW);
    if (tid == 0) { int acc = 0;
#pragma unroll
        for (int mi = 0; mi < 9; ++mi) { const unsigned long long sp = (unsigned long long)ap->dw[mi].src, dp = (unsigned long long)ap->dw[mi].dst, gp = (unsigned long long)ap->dw[mi].gain; const int K = ap->dw[mi].K, N = ap->dw[mi].N;
            d[mi * 12 + 0] = (int)(unsigned)sp; d[mi * 12 + 1] = (int)(unsigned)(sp >> 32); d[mi * 12 + 2] = (int)(unsigned)dp; d[mi * 12 + 3] = (int)(unsigned)(dp >> 32);
            d[mi * 12 + 4] = K; d[mi * 12 + 5] = N; d[mi * 12 + 6] = acc; d[mi * 12 + 7] = K / 64; d[mi * 12 + 8] = (int)(unsigned)gp; d[mi * 12 + 9] = (int)(unsigned)(gp >> 32); acc += (K / 64) * (N / 128); } }
    __syncthreads();
}
struct DenseTile { const float* src; bf16_t* dst; const float* gain; int K, N, n0, k0; };
__device__ __forceinline__ DenseTile dense_lookup(LAS unsigned char* lds, int u) {
    const LAS int* d = (const LAS int*)(lds + LDS_DW); int mi = 0;
#pragma unroll
    for (int i = 1; i < 9; ++i) if (u >= d[i * 12 + 6]) mi = i;
    mi = __builtin_amdgcn_readfirstlane(mi); const LAS int* e = d + mi * 12; DenseTile t;
    t.gain = (const float*)(((unsigned long long)(unsigned)e[9] << 32) | (unsigned)e[8]);
    t.src = (const float*)(((unsigned long long)(unsigned)e[1] << 32) | (unsigned)e[0]); t.dst = (bf16_t*)(((unsigned long long)(unsigned)e[3] << 32) | (unsigned)e[2]);
    t.K = e[4]; t.N = e[5]; const int tl = u - e[6], tk = e[7]; t.n0 = (tl / tk) * 128; t.k0 = (tl % tk) * 64; return t;
}
__device__ __forceinline__ void any_tile_load(CArgs* ap, LAS unsigned char* lds, float (&v)[16], f32x4& g0, f32x4& g1, int u, int tid) {
    if (u < ND_TILES) { const DenseTile t = dense_lookup(lds, u); ColPlain f{t.src, nullptr, t.N, t.K, nullptr}; convT_load(v, f, t.n0, t.k0, tid); convT_gain(t.gain, t.k0, tid, g0, g1); }
    else moe_tile_load(ap, v, g0, g1, u - ND_TILES, tid);
}
__device__ __forceinline__ void any_tile_store(CArgs* ap, LAS unsigned char* lds, const LAS float* tile, int u, int tid, const f32x4 g0, const f32x4 g1) {
    if (u < ND_TILES) { const DenseTile t = dense_lookup(lds, u); convT_store(tile, t.dst, t.K, t.n0, t.k0, tid, g0, g1); }
    else moe_tile_store(ap, tile, u - ND_TILES, tid, g0, g1);
}
template <bool PEEK>
__device__ __forceinline__ void conv_stream(CArgs* ap, LAS unsigned char* lds, size_t cursor_off, int lo, int hi, int max_chunks, int end_id, int tid) {
    LAS float* tile0 = (LAS float*)lds; LAS float* tile1 = tile0 + 128 * 65; LAS int* g = (LAS int*)(lds + LDS_GRAB);
    int base = 0, k = 4, chunks = 0; bool open = true;
#define CS_NEXT(dst) do { dst = -1; \
        if (k == 4 && open && chunks < max_chunks) { \
            if (tid == 0) { unsigned* cur = (unsigned*)(ap->ws + cursor_off); int got = -1; \
                if (!PEEK || lo + (int)__hip_atomic_load(cur, __ATOMIC_RELAXED, __HIP_MEMORY_SCOPE_AGENT) < end_id) got = (int)__hip_atomic_fetch_add(cur, 4u, __ATOMIC_RELAXED, __HIP_MEMORY_SCOPE_AGENT); \
                g[0] = got; } \
            __syncthreads(); const int got_ = g[0]; __syncthreads(); ++chunks; \
            if (got_ < 0 || lo + got_ >= hi) open = false; else { base = lo + got_; k = 0; if (base >= end_id) open = false; } } \
        if (k < 4) { dst = base + k; ++k; } } while (0)
    float vA[16], vB[16]; f32x4 gA0, gA1, gB0, gB1; int tA, tB;
    gA0 = gA1 = gB0 = gB1 = (f32x4){1.f, 1.f, 1.f, 1.f};
    CS_NEXT(tA); if (tA < 0) return; any_tile_load(ap, lds, vA, gA0, gA1, tA, tid);
    CS_NEXT(tB); if (tB >= 0) any_tile_load(ap, lds, vB, gB0, gB1, tB, tid);
    for (;;) {
        convT_put(tile0, vA, tid); __syncthreads();
        const int sA = tA; const f32x4 hA0 = gA0, hA1 = gA1; tA = -1; if (tB >= 0) { CS_NEXT(tA); } if (tA >= 0) any_tile_load(ap, lds, vA, gA0, gA1, tA, tid);
        any_tile_store(ap, lds, tile0, sA, tid, hA0, hA1);
        if (tB < 0) break;
        convT_put(tile1, vB, tid); __syncthreads();
        const int sB = tB; const f32x4 hB0 = gB0, hB1 = gB1; tB = -1; if (tA >= 0) { CS_NEXT(tB); } if (tB >= 0) any_tile_load(ap, lds, vB, gB0, gB1, tB, tid);
        any_tile_store(ap, lds, tile1, sB, tid, hB0, hB1);
        if (tA < 0) break;
    }
#undef CS_NEXT
    __syncthreads();
}
constexpr int CONV_NOLIMIT = 0x3fffffff;
__device__ __forceinline__ void tail_convert(CArgs* ap, LAS unsigned char* lds, int quota, int tid) {
    if (quota <= 0) return; conv_stream<false>(ap, lds, CTL_CURSOR, ND_TILES + MOE_GU_TILES, ND_TILES + MOE_ALL_TILES, (quota + 3) / 4, CONV_NOLIMIT, tid);
}
__device__ __forceinline__ void catchup_convert(CArgs* ap, LAS unsigned char* lds, int end_tile, int tid) {
    conv_stream<true>(ap, lds, CTL_CURSOR, ND_TILES + MOE_GU_TILES, ND_TILES + MOE_ALL_TILES, CONV_NOLIMIT, ND_TILES + end_tile, tid);
}
__device__ __forceinline__ void prologue_weights(const Args __attribute__((address_space(4)))* ap, LAS unsigned char* lds, int tid) {
    LAS float* tile = (LAS float*)lds;
    const int G = GRID_N, bid = BLOCK_ID;
    dense_desc_build(ap, lds, tid);
    conv_stream<false>(ap, lds, CTL_CURSOR0, 0, ND_TILES + MOE_GU_TILES, CONV_NOLIMIT, CONV_NOLIMIT, tid);
    { const float* wa = ap->in[I_LRU_W_A]; const float* wx = ap->in[I_LRU_W_X]; bf16_t* dst = (bf16_t*)(ap->ws + WS_W_LRU_G);
      for (int it = bid * NTHREADS + tid; it < 8 * 1024 * 32; it += G * NTHREADS) {
          const int kk0 = (it & 31) * 8, c = (it >> 5) & 1023, p = it >> 15;
          const int dir = c >> 9, cp = c & 511, q = cp >> 5, gate = (cp >> 4) & 1, chl = 16 * q + (cp & 15), hb = 2 * p + (chl >> 7), j = chl & 127;
          float v[8];
          if ((kk0 >> 7) == (chl >> 7)) { const float* s = (gate ? wx : wa) + (((size_t)dir * 16 + hb) * 128 + (kk0 & 127)) * 128 + j;
#pragma unroll
              for (int e = 0; e < 8; ++e) v[e] = s[(size_t)e * 128]; }
          else {
#pragma unroll
              for (int e = 0; e < 8; ++e) v[e] = 0.f; }
          u32x4 w; w.x = cvt_pk_bf16(v[0], v[1]); w.y = cvt_pk_bf16(v[2], v[3]); w.z = cvt_pk_bf16(v[4], v[5]); w.w = cvt_pk_bf16(v[6], v[7]);
          *(u32x4*)(dst + ((size_t)p * 1024 + c) * 256 + kk0) = w; } }
    { const int* pos = (const int*)ap->in[I_POS]; float* cs = (float*)(ap->ws + WS_ROPE);
      for (int it = bid * NTHREADS + tid; it < S_ * 16; it += G * NTHREADS) { const int t = it >> 4, i = it & 15;
          float sn, cn; sincos_d((double)pos[t] * ROPE_INV[i], sn, cn);
          cs[t * 32 + i] = cn; cs[t * 32 + 16 + i] = sn; } }
    { const float* lam = ap->in[I_LRU_LAMBDA]; float* spt = (float*)(ap->ws + WS_SPT); for (int it = bid * NTHREADS + tid; it < 2 * 2048; it += G * NTHREADS) spt[it] = log1pf(expf(-lam[it])); }
    { const float* wg = ap->in[I_MOE_W_GROUP]; const float* we = ap->in[I_MOE_W_EXPERT]; const float* gf = ap->in[I_LN_FFN]; float* wrt = (float*)(ap->ws + WS_WRT);
      for (int it = bid * NTHREADS + tid; it < 4 * 36 * 2048; it += G * NTHREADS) { const int k = it & 2047, j = (it >> 11) % 36, l = it / (36 * 2048);
          const float w = (j < 4) ? wg[((size_t)l * 2048 + k) * 4 + j] : we[((size_t)l * 2048 + k) * 32 + (j - 4)]; wrt[it] = w * gf[l * 2048 + k]; } }
    { bf16_t* X = (bf16_t*)(ap->ws + WS_X); if (bid == 0) for (int i = tid; i < 2048; i += NTHREADS) X[(size_t)S_ * 2048 + i] = 0; }
}

__device__ __forceinline__ void s5_tables(const Args __attribute__((address_space(4)))* ap, LAS unsigned char* lds, int g, int tid) {
    LAS float* LP = (LAS float*)lds;
    LAS float* BB = LP + 2 * 64 * 17 * 2;
    LAS float* CC = BB + 2 * 64 * 16 * 2;
    LAS float* KT = CC + 2 * 16 * 64 * 2;
    const float* a_re = ap->in[I_S5_A_RE]; const float* a_im = ap->in[I_S5_A_IM]; const float* log_dt = ap->in[I_S5_LOG_DT];
    const float* b_re = ap->in[I_S5_B_RE]; const float* b_im = ap->in[I_S5_B_IM]; const float* c_re = ap->in[I_S5_C_RE]; const float* c_im = ap->in[I_S5_C_IM];
    if (tid < 128) { const int dir = tid >> 6, n = tid & 63; const size_t sn = ((size_t)dir * 64 + g) * 64 + n;
        const float ar = a_re[sn], ai = a_im[sn]; const float dt = expf(log_dt[dir * 64 + g]);
        const float mag = expf(dt * ar); float sv, cv; sincos_d((double)dt * (double)ai, sv, cv); const float lr = mag * cv, li = mag * sv;
        const float den = ar * ar + ai * ai, nr = lr - 1.0f, ni = li; const float fr = (nr * ar + ni * ai) / den, fi = (ni * ar - nr * ai) / den;
        float pr = 1.f, pi = 0.f;
        for (int j = 0; j <= 16; ++j) { LP[((dir * 64 + n) * 17 + j) * 2] = pr; LP[((dir * 64 + n) * 17 + j) * 2 + 1] = pi; const float t = pr * lr - pi * li; pi = pr * li + pi * lr; pr = t; }
        float* lam16 = (float*)(ap->ws + WS_S5_LAM) + (((size_t)g * 2 + dir) * 64 + n) * 2;
        lam16[0] = LP[((dir * 64 + n) * 17 + 16) * 2]; lam16[1] = LP[((dir * 64 + n) * 17 + 16) * 2 + 1];
        for (int ci = 0; ci < 16; ++ci) { const float br = b_re[sn * 16 + ci], bi = b_im[sn * 16 + ci];
            BB[((dir * 64 + n) * 16 + ci) * 2] = fr * br - fi * bi; BB[((dir * 64 + n) * 16 + ci) * 2 + 1] = fr * bi + fi * br; } }
    for (int it = tid; it < 2 * 16 * 64; it += NTHREADS) { const int dir = it >> 10, co = (it >> 6) & 15, n = it & 63; const size_t s = (((size_t)dir * 64 + g) * 16 + co) * 64 + n;
        CC[it * 2] = c_re[s]; CC[it * 2 + 1] = c_im[s]; }
    __syncthreads();
    for (int it = tid; it < 2 * 16 * 256; it += NTHREADS) { const int dir = it >> 12, j = (it >> 8) & 15, co = (it >> 4) & 15, ci = it & 15; float s = 0.f;
        for (int n = 0; n < 64; ++n) { const float pr = LP[((dir * 64 + n) * 17 + j) * 2], pi = LP[((dir * 64 + n) * 17 + j) * 2 + 1];
            const float br = BB[((dir * 64 + n) * 16 + ci) * 2], bi = BB[((dir * 64 + n) * 16 + ci) * 2 + 1];
            const float qr = pr * br - pi * bi, qi = pr * bi + pi * br;
            const float cr = CC[((dir * 16 + co) * 64 + n) * 2], ci_ = CC[((dir * 16 + co) * 64 + n) * 2 + 1];
            s += cr * qr - ci_ * qi; }
        KT[it] = s; }
    { bf16_t* Et = (bf16_t*)(ap->ws + WS_S5_E) + (size_t)g * 256 * 256;
      for (int it = tid; it < 256 * 128; it += NTHREADS) { const int nidx = it >> 7, k = (it & 127) * 2; const int dir = nidx >> 7, n = (nidx & 127) >> 1, ri = nidx & 1;
          float v[2];
#pragma unroll
          for (int e = 0; e < 2; ++e) { const int l = (k + e) >> 4, ci = (k + e) & 15, pw = dir ? l : 15 - l;
              const float pr = LP[((dir * 64 + n) * 17 + pw) * 2], pi = LP[((dir * 64 + n) * 17 + pw) * 2 + 1];
              const float br = BB[((dir * 64 + n) * 16 + ci) * 2], bi = BB[((dir * 64 + n) * 16 + ci) * 2 + 1];
              v[e] = ri ? (pr * bi + pi * br) : (pr * br - pi * bi); }
          *(unsigned*)(Et + (size_t)nidx * 256 + k) = cvt_pk_bf16(v[0], v[1]); } }
    __syncthreads();
    { bf16_t* TF = (bf16_t*)(ap->ws + WS_S5_TF) + (size_t)g * 256 * 512;
      for (int it = tid; it < 256 * 256; it += NTHREADS) { const int nn = it >> 8, k = (it & 255) * 2; const int lt = nn >> 4, co = nn & 15;
          float v[2];
#pragma unroll
          for (int e = 0; e < 2; ++e) { const int kk = k + e;
              if (kk < 256) { const int ls = kk >> 4, ci = kk & 15; float s = 0.f;
                  if (lt >= ls) s += KT[((0 * 16 + (lt - ls)) * 16 + co) * 16 + ci];
                  if (ls >= lt) s += KT[((1 * 16 + (ls - lt)) * 16 + co) * 16 + ci];
                  v[e] = s; }
              else { const int nidx = kk - 256, dir = nidx >> 7, n = (nidx & 127) >> 1, ri = nidx & 1, pw = dir ? 16 - lt : lt + 1;
                  const float pr = LP[((dir * 64 + n) * 17 + pw) * 2], pi = LP[((dir * 64 + n) * 17 + pw) * 2 + 1];
                  const float cr = CC[((dir * 16 + co) * 64 + n) * 2], ci_ = CC[((dir * 16 + co) * 64 + n) * 2 + 1];
                  const float qr = cr * pr - ci_ * pi, qi = cr * pi + ci_ * pr;
                  v[e] = ri ? -qi : qr; } }
          *(unsigned*)(TF + (size_t)nn * 512 + k) = cvt_pk_bf16(v[0], v[1]); } }
    __syncthreads();
}

__device__ __forceinline__ void moe_table(const unsigned* cnt, LAS unsigned char* lds, int tid) {
    LAS int* tle = (LAS int*)(lds + LDS_TLE); LAS int* tli = (LAS int*)(lds + LDS_TLI); LAS int* lc = (LAS int*)(lds + LDS_CNT); LAS int* tb = (LAS int*)(lds + LDS_TB); LAS int* nt = (LAS int*)(lds + LDS_NT);
    if (tid < 64) { const int e = tid & 31; const int c = (int)cnt[e * 16]; const int tiles = (c + 255) >> 8; int incl = tiles;
#pragma unroll
        for (int d = 1; d < 32; d <<= 1) { const int v = __shfl_up(incl, d, 32); if (e >= d) incl += v; }
        const int start = incl - tiles;
        if (tid < 32) { lc[e] = c; tb[e] = start;
            for (int i = 0; i < tiles; ++i) if (start + i < MAXTILES) { tle[start + i] = e; tli[start + i] = i; }
            if (e == 31) nt[0] = incl < MAXTILES ? incl : MAXTILES; } }
    __syncthreads();
}
template <int MODE, bool FINAL, bool SRCBF>
__device__ __forceinline__ void norm_phase(const void* src, bf16_t* dstX, const float* gvec, bf16_t* H, float* RS, float* OUT,
                                           const bf16_t* ys, const int* tope, const float* topw, const int* slot, const unsigned* cnt, LAS unsigned char* lds, int tid) {
    const int lane = tid & 63, wid = tid >> 6; const int nw = GRID_N * 8;
    LAS int* tb = (LAS int*)(lds + LDS_TB);
    if (MODE == 1 && MK_SPLIT) moe_table(cnt, lds, tid);
    f32x4 gv[8];
#pragma unroll
    for (int i = 0; i < 8; ++i) gv[i] = *(const f32x4*)(gvec + i * 256 + lane * 4);
    for (int rowA = BLOCK_ID * 8 + wid; rowA < S_; rowA += 2 * nw) {
        const int rowB = rowA + nw; const bool hasB = rowB < S_; const int rB = hasB ? rowB : rowA;
        int e0[2] = {0, 0}, e1[2] = {0, 0}, s0[2] = {0, 0}, s1[2] = {0, 0}; float w0[2] = {0.f, 0.f}, w1[2] = {0.f, 0.f};
        if (MODE == 1) {
#pragma unroll
            for (int r = 0; r < 2; ++r) { const int row = r ? rB : rowA; e0[r] = tope[row * 2]; e1[r] = tope[row * 2 + 1]; w0[r] = topw[row * 2]; w1[r] = topw[row * 2 + 1]; s0[r] = slot[row * 2]; s1[r] = slot[row * 2 + 1]; } }
        f32x4 v[2][8]; u32x2 xb[2][8];
#pragma unroll
        for (int r = 0; r < 2; ++r) { const int row = r ? rB : rowA;
            if (SRCBF) { const bf16_t* xr = (const bf16_t*)src + (size_t)row * 2048;
#pragma unroll
                for (int i = 0; i < 8; ++i) xb[r][i] = *(const u32x2*)(xr + i * 256 + lane * 4); }
            else { const float* xr = (const float*)src + (size_t)row * 2048;
#pragma unroll
                for (int i = 0; i < 8; ++i) v[r][i] = *(const f32x4*)(xr + i * 256 + lane * 4); } }
        u32x2 a0[2][8], a1[2][8];
        if (MODE == 1) {
#pragma unroll
            for (int r = 0; r < 2; ++r) { const bf16_t* y0 = ys + ((size_t)tb[e0[r]] * 256 + s0[r]) * 2048; const bf16_t* y1 = ys + ((size_t)tb[e1[r]] * 256 + s1[r]) * 2048;
#pragma unroll
                for (int i = 0; i < 8; ++i) { a0[r][i] = *(const u32x2*)(y0 + i * 256 + lane * 4); a1[r][i] = *(const u32x2*)(y1 + i * 256 + lane * 4); } } }
        asm volatile("" ::: "memory");
#pragma unroll
        for (int r = 0; r < 2; ++r) { const int row = r ? rowB : rowA; if (r == 1 && !hasB) break;
            if (SRCBF) {
#pragma unroll
                for (int i = 0; i < 8; ++i) v[r][i] = (f32x4){bflo(xb[r][i].x), bfhi(xb[r][i].x), bflo(xb[r][i].y), bfhi(xb[r][i].y)}; }
            if (MODE == 1) {
#pragma unroll
                for (int i = 0; i < 8; ++i) {
                    v[r][i][0] += w0[r] * bflo(a0[r][i].x) + w1[r] * bflo(a1[r][i].x); v[r][i][1] += w0[r] * bfhi(a0[r][i].x) + w1[r] * bfhi(a1[r][i].x);
                    v[r][i][2] += w0[r] * bflo(a0[r][i].y) + w1[r] * bflo(a1[r][i].y); v[r][i][3] += w0[r] * bfhi(a0[r][i].y) + w1[r] * bfhi(a1[r][i].y); } }
            if (dstX) {
#pragma unroll
                for (int i = 0; i < 8; ++i) { u32x2 w; w.x = cvt_pk_bf16(v[r][i][0], v[r][i][1]); w.y = cvt_pk_bf16(v[r][i][2], v[r][i][3]); *(u32x2*)(dstX + (size_t)row * 2048 + i * 256 + lane * 4) = w; } }
            float ss = 0.f;
#pragma unroll
            for (int i = 0; i < 8; ++i) ss += v[r][i][0] * v[r][i][0] + v[r][i][1] * v[r][i][1] + v[r][i][2] * v[r][i][2] + v[r][i][3] * v[r][i][3];
            ss = wave_sum(ss); const float rstd = rsqrtf(ss * (1.0f / 2048.0f) + NORM_EPS);
            if (FINAL) {
#pragma unroll
                for (int i = 0; i < 8; ++i) { const f32x4 y = v[r][i] * rstd * gv[i]; *(f32x4*)(OUT + (size_t)row * 2048 + i * 256 + lane * 4) = y; } }
            else {
                if (lane == 0) RS[row] = rstd;
                if (!SRCBF) {
#pragma unroll
                    for (int i = 0; i < 8; ++i) { u32x2 w; w.x = cvt_pk_bf16(v[r][i][0], v[r][i][1]); w.y = cvt_pk_bf16(v[r][i][2], v[r][i][3]); *(u32x2*)(H + (size_t)row * 2048 + i * 256 + lane * 4) = w; } } } }
    }
}

__device__ __forceinline__ void router_phase(const bf16_t* __restrict__ X, float* __restrict__ rsg, const float* __restrict__ WRT,
                                             int* __restrict__ tope, float* __restrict__ topw, int* __restrict__ slot, int* __restrict__ rowtok, unsigned* cnt, LAS unsigned char* lds, int tid) {
    LAS float* part = (LAS float*)lds;
    LAS float* ssp = part + 8 * 32 * 36;
    LAS float* lg = ssp + 8 * 64;
    LAS float* rs = lg + 32 * 36;
    LAS float* w1s = (LAS float*)(lds + 45056);
    LAS float* gp = w1s + 4 * 2048;
    const int lane = tid & 63, wid = tid >> 6, i = lane & 31, h = lane >> 5;
    const int gstep32 = GRID_N * 32;
#pragma unroll
    for (int q = 0; q < 4; ++q) *(LAS f32x4*)(w1s + (q * 512 + tid) * 4) = *(const f32x4*)(WRT + (size_t)32 * 2048 + (q * 512 + tid) * 4);
    __syncthreads();
    for (int base = BLOCK_ID * 32; base < S_; base += gstep32) {
        { const bf16_t* xp = X + (size_t)(base + i) * 2048 + wid * 256 + 4 * h; const float* w0p = WRT + (size_t)i * 2048 + wid * 256 + 4 * h; const LAS float* w1l = w1s + wid * 256 + 4 * h;
          f32x16 acc0 = {}; f32x4 gacc = (f32x4){0.f, 0.f, 0.f, 0.f}; float ss = 0.f;
#pragma unroll
          for (int g = 0; g < 8; ++g) { u32x2 xq[4]; f32x4 b0q[4];
#pragma unroll
              for (int j = 0; j < 4; ++j) { const int m = g * 4 + j; xq[j] = *(const u32x2*)(xp + 8 * m); b0q[j] = *(const f32x4*)(w0p + 8 * m); }
              asm volatile("" ::: "memory");
#pragma unroll
              for (int j = 0; j < 4; ++j) asm volatile("" : "+v"(xq[j]), "+v"(b0q[j]));
#pragma unroll
              for (int j = 0; j < 4; ++j) { const int m = g * 4 + j;
                  const u32x2 xw_ = xq[j]; const f32x4 xa = (f32x4){bflo(xw_.x), bfhi(xw_.x), bflo(xw_.y), bfhi(xw_.y)}; const f32x4 b0 = b0q[j];
                  ss += xa[0] * xa[0] + xa[1] * xa[1] + xa[2] * xa[2] + xa[3] * xa[3];
#pragma unroll
                  for (int e = 0; e < 4; ++e) acc0 = __builtin_amdgcn_mfma_f32_32x32x2f32(xa[e], b0[e], acc0, 0, 0, 0);
#pragma unroll
                  for (int c = 0; c < 4; ++c) { const f32x4 wv = *(const LAS f32x4*)(w1l + c * 2048 + 8 * m); gacc[c] += xa[0] * wv[0] + xa[1] * wv[1] + xa[2] * wv[2] + xa[3] * wv[3]; }
                  asm volatile("" : "+v"(gacc) :: "memory"); }
              asm volatile("" ::: "memory"); }
#pragma unroll
          for (int r = 0; r < 16; ++r) { const int row = (r & 3) + 8 * (r >> 2) + 4 * h; part[(wid * 32 + row) * 36 + i] = acc0[r]; }
          *(LAS f32x4*)(gp + ((wid * 2 + h) * 32 + i) * 4) = gacc;
          ssp[(wid * 2 + h) * 32 + i] = ss; }
        __syncthreads();
        if (tid < 32) { float s = 0.f;
#pragma unroll
            for (int q = 0; q < 16; ++q) s += ssp[q * 32 + tid];
            rs[tid] = rsqrtf(s * (1.0f / 2048.0f) + NORM_EPS); }
        __syncthreads();
        for (int it = tid; it < 32 * 36; it += NTHREADS) { const int t = it / 36, j = it % 36; float s = 0.f;
            if (j < 32) {
#pragma unroll
                for (int w = 0; w < 8; ++w) s += part[(w * 32 + t) * 36 + j]; }
            else {
#pragma unroll
                for (int q = 0; q < 16; ++q) s += gp[(q * 32 + t) * 4 + (j - 32)]; }
            lg[it] = s * rs[t]; }
        __syncthreads();
        if (tid < 32) { const int t = tid, row = base + t; const LAS float* L = lg + t * 36;
            int gi = 0; float gm = L[0];
#pragma unroll
            for (int q = 1; q < 4; ++q) if (L[q] > gm) { gm = L[q]; gi = q; }
            float gs = 0.f;
#pragma unroll
            for (int q = 0; q < 4; ++q) gs += __expf(L[q] - gm);
            const float gp = 1.0f / gs;
            float el[8]; int i1 = 0; float m1 = -3.4e38f;
#pragma unroll
            for (int q = 0; q < 8; ++q) { el[q] = L[4 + gi * 8 + q]; if (el[q] > m1) { m1 = el[q]; i1 = q; } }
            int i2 = 0; float m2 = -3.4e38f;
#pragma unroll
            for (int q = 0; q < 8; ++q) if (q != i1 && el[q] > m2) { m2 = el[q]; i2 = q; }
            const float p2 = __expf(m2 - m1); const float w1 = gp / (1.0f + p2), w2 = gp * p2 / (1.0f + p2);
            const int e1 = gi * 8 + i1, e2 = gi * 8 + i2;
            const int s1 = (int)atomicAdd(&cnt[e1 * 16], 1u), s2 = (int)atomicAdd(&cnt[e2 * 16], 1u);
            rowtok[e1 * 8192 + s1] = row; rowtok[e2 * 8192 + s2] = row; { const float rv = rs[t]; rsg[e1 * 8192 + s1] = rv; rsg[e2 * 8192 + s2] = rv; }
            tope[row * 2] = e1; tope[row * 2 + 1] = e2; topw[row * 2] = w1; topw[row * 2 + 1] = w2; slot[row * 2] = s1; slot[row * 2 + 1] = s2; }
        __syncthreads();
    }
}

__device__ __forceinline__ void lru_conv_phase(const bf16_t* __restrict__ xrp, const float* __restrict__ cw, const float* __restrict__ cb, bf16_t* __restrict__ xr, int tid) {
    const int gstepT = GRID_N * NTHREADS;
    for (int it = BLOCK_ID * NTHREADS + tid; it < (S_ / 16) * 256; it += gstepT) {
        const int t0 = (it >> 8) * 16, c = (it & 255) * 8;
        u32x4 xin[19];
#pragma unroll
        for (int r = 0; r < 19; ++r) { const int ts = t0 + r - 2; xin[r] = (ts >= 0 && ts < S_) ? *(const u32x4*)(xrp + (size_t)ts * 2048 + c) : (u32x4){0u, 0u, 0u, 0u}; }
        f32x4 w0[4], w1[4];
#pragma unroll
        for (int k = 0; k < 4; ++k) { w0[k] = *(const f32x4*)(cw + k * 2048 + c); w1[k] = *(const f32x4*)(cw + k * 2048 + c + 4); }
        const f32x4 b0 = *(const f32x4*)(cb + c), b1 = *(const f32x4*)(cb + c + 4);
        asm volatile("" ::: "memory");
#pragma unroll
        for (int o = 0; o < 16; ++o) { f32x4 a0 = b0, a1 = b1;
#pragma unroll
            for (int k = 0; k < 4; ++k) { const u32x4 xw = xin[o + k];
                a0[0] += w0[k][0] * bflo(xw.x); a0[1] += w0[k][1] * bfhi(xw.x); a0[2] += w0[k][2] * bflo(xw.y); a0[3] += w0[k][3] * bfhi(xw.y);
                a1[0] += w1[k][0] * bflo(xw.z); a1[1] += w1[k][1] * bfhi(xw.z); a1[2] += w1[k][2] * bflo(xw.w); a1[3] += w1[k][3] * bfhi(xw.w); }
            u32x4 w; w.x = cvt_pk_bf16(a0[0], a0[1]); w.y = cvt_pk_bf16(a0[2], a0[3]); w.z = cvt_pk_bf16(a1[0], a1[1]); w.w = cvt_pk_bf16(a1[2], a1[3]);
            *(u32x4*)(xr + (size_t)(t0 + o) * 2048 + c) = w; }
    }
}
__device__ __forceinline__ void lru_scan1(const unsigned* __restrict__ LAB, float* __restrict__ CHA, float* __restrict__ CHB, int tid) {
    const int gstepT = GRID_N * NTHREADS;
    for (int it = BLOCK_ID * NTHREADS + tid; it < 2 * NCH * 512; it += gstepT) {
        const int c4 = (it & 511) * 4, ch = (it >> 9) & (NCH - 1), dir = it >> 16;
        f32x4 h = (f32x4){0.f, 0.f, 0.f, 0.f}, LS = (f32x4){0.f, 0.f, 0.f, 0.f};
        const unsigned* base = LAB + ((size_t)dir * S_ + (size_t)ch * CHL) * 2048 + c4;
        u32x4 wa[16], wb[16];
#pragma unroll
        for (int s = 0; s < 16; ++s) { const int tt = dir ? (CHL - 1 - s) : s; wa[s] = *(const u32x4*)(base + (size_t)tt * 2048); }
#pragma unroll
        for (int gq = 0; gq < CHL / 16; ++gq) {
            if (gq + 1 < CHL / 16) {
#pragma unroll
                for (int s = 0; s < 16; ++s) { const int s2 = (gq + 1) * 16 + s; const int tt = dir ? (CHL - 1 - s2) : s2; wb[s] = *(const u32x4*)(base + (size_t)tt * 2048); } }
            asm volatile("" ::: "memory");
#pragma unroll
            for (int s = 0; s < 16; ++s) { const u32x4 w = wa[s];
#pragma unroll
                for (int j = 0; j < 4; ++j) { const float la = bflo(w[j]); h[j] = __expf(la) * h[j] + bfhi(w[j]); LS[j] += la; } }
#pragma unroll
            for (int s = 0; s < 16; ++s) wa[s] = wb[s];
        }
        f32x4 P; P[0] = __expf(LS[0]); P[1] = __expf(LS[1]); P[2] = __expf(LS[2]); P[3] = __expf(LS[3]);
        *(f32x4*)(CHA + ((size_t)dir * NCH + ch) * 2048 + c4) = P; *(f32x4*)(CHB + ((size_t)dir * NCH + ch) * 2048 + c4) = h; }
}
__device__ __forceinline__ void lru_scan3(const unsigned* __restrict__ LAB, const float* __restrict__ CHA, const float* __restrict__ CHB, const bf16_t* __restrict__ gate, bf16_t* __restrict__ yg, int tid) {
    const int gstepT = GRID_N * NTHREADS;
    for (int it = BLOCK_ID * NTHREADS + tid; it < NCH * 2048; it += gstepT) {
        const int c = it & 2047, ch = it >> 11; float hf[CHL];
        float cf = 0.f, cb = 0.f;
        for (int q0 = 0; q0 < ch; q0 += 32) { float a_[32], b_[32];
#pragma unroll
            for (int i = 0; i < 32; ++i) { const int q = (q0 + i < ch) ? q0 + i : ch - 1; const size_t o = ((size_t)0 * NCH + q) * 2048 + c; a_[i] = CHA[o]; b_[i] = CHB[o]; }
            asm volatile("" ::: "memory");
#pragma unroll
            for (int i = 0; i < 32; ++i) cf = (q0 + i < ch) ? a_[i] * cf + b_[i] : cf; }
        for (int q0 = NCH - 1; q0 > ch; q0 -= 32) { float a_[32], b_[32];
#pragma unroll
            for (int i = 0; i < 32; ++i) { const int q = (q0 - i > ch) ? q0 - i : ch + 1; const size_t o = ((size_t)1 * NCH + q) * 2048 + c; a_[i] = CHA[o]; b_[i] = CHB[o]; }
            asm volatile("" ::: "memory");
#pragma unroll
            for (int i = 0; i < 32; ++i) cb = (q0 - i > ch) ? a_[i] * cb + b_[i] : cb; }
        { float h = cf; const unsigned* base = LAB + ((size_t)0 * S_ + (size_t)ch * CHL) * 2048 + c; unsigned wf[CHL];
#pragma unroll
          for (int s = 0; s < CHL; ++s) wf[s] = base[(size_t)s * 2048];
          asm volatile("" ::: "memory");
#pragma unroll
          for (int s = 0; s < CHL; s += 16) asm volatile("" : "+v"(wf[s]), "+v"(wf[s + 1]), "+v"(wf[s + 2]), "+v"(wf[s + 3]), "+v"(wf[s + 4]), "+v"(wf[s + 5]), "+v"(wf[s + 6]), "+v"(wf[s + 7]),
                                                             "+v"(wf[s + 8]), "+v"(wf[s + 9]), "+v"(wf[s + 10]), "+v"(wf[s + 11]), "+v"(wf[s + 12]), "+v"(wf[s + 13]), "+v"(wf[s + 14]), "+v"(wf[s + 15]));
#pragma unroll
          for (int s = 0; s < CHL; ++s) { h = __expf(bflo(wf[s])) * h + bfhi(wf[s]); hf[s] = h; } }
        { float h = cb; const unsigned* base = LAB + ((size_t)1 * S_ + (size_t)ch * CHL) * 2048 + c; const size_t gb = ((size_t)ch * CHL) * 2048 + c; unsigned wb[CHL]; bf16_t gv[CHL];
#pragma unroll
          for (int s = 0; s < CHL; ++s) { wb[s] = base[(size_t)s * 2048]; gv[s] = gate[gb + (size_t)s * 2048]; }
          asm volatile("" ::: "memory");
#pragma unroll
          for (int s = CHL - 1; s >= 0; --s) { h = __expf(bflo(wb[s])) * h + bfhi(wb[s]); yg[gb + (size_t)s * 2048] = f2bf((hf[s] + h) * bf2f(gv[s])); } }
    }
}

__device__ __forceinline__ void diff_combine(const bf16_t* O, const float* lq1, const float* lk1, const float* lq2, const float* lk2, const float* subg, float lam_init, bf16_t* OD, int tid) {
    const int lane = tid & 63, wid = tid >> 6;
    const float s1 = wave_sum(lq1[lane] * lk1[lane] + lq1[lane + 64] * lk1[lane + 64]), s2 = wave_sum(lq2[lane] * lk2[lane] + lq2[lane + 64] * lk2[lane + 64]);
    const float lam = expf(s1) - expf(s2) + lam_init;
    const int half = lane >> 5, d = (lane & 31) * 4; const f32x4 gv = *(const f32x4*)(subg + half * 128 + d);
    const int gstep8 = GRID_N * 8;
    for (int it = BLOCK_ID * 8 + wid; it < S_ * 8; it += gstep8) { const int t = it >> 3, h = it & 7;
        const u32x2 a0 = *(const u32x2*)(O + (size_t)t * 4096 + ((h * 2 + 0) * 2 + half) * 128 + d), a1 = *(const u32x2*)(O + (size_t)t * 4096 + ((h * 2 + 1) * 2 + half) * 128 + d);
        f32x4 o; o[0] = bflo(a0.x) - lam * bflo(a1.x); o[1] = bfhi(a0.x) - lam * bfhi(a1.x); o[2] = bflo(a0.y) - lam * bflo(a1.y); o[3] = bfhi(a0.y) - lam * bfhi(a1.y);
        const float ss = wave_sum(o[0] * o[0] + o[1] * o[1] + o[2] * o[2] + o[3] * o[3]); const float sc = rsqrtf(ss * (1.0f / 256.0f) + NORM_EPS) * (1.0f - lam_init);
        u32x2 w; w.x = cvt_pk_bf16(o[0] * sc * gv[0], o[1] * sc * gv[1]); w.y = cvt_pk_bf16(o[2] * sc * gv[2], o[3] * sc * gv[3]);
        *(u32x2*)(OD + (size_t)t * 2048 + h * 256 + half * 128 + d) = w; }
}

__device__ __forceinline__ void s5_carry(const float* __restrict__ SL, const float* __restrict__ lam16, bf16_t* __restrict__ UA, LAS unsigned char* lds, int tid) {
    LAS float* ex = (LAS float*)lds;
    const int cl = tid & 31, seg = tid >> 5; const int gstep = GRID_N;
    for (int item = BLOCK_ID; item < 256; item += gstep) {
        const int chain = item * 32 + cl, g = chain >> 7, dn = chain & 127, dir = dn >> 6, n = dn & 63;
        const float lr = lam16[(((size_t)g * 2 + dir) * 64 + n) * 2], li = lam16[(((size_t)g * 2 + dir) * 64 + n) * 2 + 1];
        const int nidx = dir * 128 + 2 * n;
        const float* sl = SL + (size_t)g * 512 * 256 + nidx; bf16_t* ua = UA + (size_t)g * 512 * 512 + 256 + nidx;
        f32x2 e[32];
#pragma unroll
        for (int s_ = 0; s_ < 32; ++s_) { const int q = seg * 32 + s_, c = dir ? (511 - q) : q; e[s_] = *(const f32x2*)(sl + (size_t)c * 256); }
        float sr = 0.f, si = 0.f;
#pragma unroll
        for (int s_ = 0; s_ < 32; ++s_) { const float tr = lr * sr - li * si + e[s_][0]; si = lr * si + li * sr + e[s_][1]; sr = tr; }
        ex[(cl * 16 + seg) * 2] = sr; ex[(cl * 16 + seg) * 2 + 1] = si;
        float mr = lr, mi = li;
#pragma unroll
        for (int k = 0; k < 5; ++k) { const float tr = mr * mr - mi * mi; mi = 2.f * mr * mi; mr = tr; }
        __syncthreads();
        float cr = 0.f, ci = 0.f;
        for (int p_ = 0; p_ < seg; ++p_) { const float er = ex[(cl * 16 + p_) * 2], ei = ex[(cl * 16 + p_) * 2 + 1]; const float tr = mr * cr - mi * ci + er; ci = mr * ci + mi * cr + ei; cr = tr; }
        sr = cr; si = ci;
#pragma unroll
        for (int s_ = 0; s_ < 32; ++s_) { const int q = seg * 32 + s_, c = dir ? (511 - q) : q;
            *(unsigned*)(ua + (size_t)c * 512) = cvt_pk_bf16(sr, si);
            const float tr = lr * sr - li * si + e[s_][0]; si = lr * si + li * sr + e[s_][1]; sr = tr; }
        __syncthreads();
    }
}

template <bool GATHER_>
struct MoeSched {
    static constexpr bool GATHER = GATHER_;
    const LAS int* tle; const LAS int* tli; const LAS int* lc; const int* rowtok; const char* A; const char* W; size_t a_tile, b_tile; int ntiles, nN, G, c, rep;
    __device__ __forceinline__ int my_units() const { if (G != 256) { const long n = (long)ntiles * nN; return (int)((n - c + G - 1) / G > 0 ? (n - c + G - 1) / G : 0); }
        const int x = c & 7, k = c >> 3; int cnt; if (nN == 4) { const int h0 = (ntiles + 1) >> 1; cnt = (x >> 2) ? ntiles - h0 : h0; } else cnt = (((x + 1) * ntiles) / 8 - (x * ntiles) / 8) * 8; return cnt > k ? (cnt - k + 31) >> 5 : 0; }
    __device__ __forceinline__ int max_units() const { if (G != 256) return (int)(((long)ntiles * nN + G - 1) / G); const int cnt = (nN == 4) ? (ntiles + 1) >> 1 : ((ntiles + 7) / 8) * 8; return (cnt + 31) >> 5; }
    __device__ __forceinline__ bool next(int i, pg::Unit& u) const {
        int rt, pn;
        if (G == 256) { const int x = c & 7, k = c >> 3, j = (i % (my_units() > 0 ? my_units() : 1)) * 32 + k; if (i >= my_units() * rep) return false;
            if (nN == 4) { const int h0 = (ntiles + 1) >> 1; pn = x & 3; rt = ((x >> 2) ? h0 : 0) + j; } else { pn = j & 7; rt = (x * ntiles) / 8 + (j >> 3); } }
        else { const long L0 = (long)i * G + c; if (L0 >= (long)ntiles * nN * rep) return false; const long L = L0 % ((long)ntiles * nN); rt = (int)(L / nN); pn = (int)(L % nN); }
        u.pn = pn; u.aux = rt; u.g = tle[rt]; u.pm = tli[rt]; return true;
    }
    __device__ __forceinline__ const char* a_base(const pg::Unit& u) const { return GATHER ? A : A + (size_t)u.aux * a_tile; }
    __device__ __forceinline__ const char* b_base(const pg::Unit& u) const { return W + (size_t)u.g * MOE_LE_B + (size_t)u.pn * b_tile; }
    __device__ __forceinline__ int a_row(const pg::Unit& u, int r) const { const int idx = u.pm * 256 + r; return (idx < lc[u.g]) ? rowtok[u.g * 8192 + idx] : S_; }
};
#ifndef CFG_MIX
#define CFG_MIX 0xF
#endif
#ifndef CFG_MOE
#define CFG_MOE 0xF
#endif
constexpr int NPH = 37;
#ifndef PH_MASK
#define PH_MASK 0xFFFFFFFFFFFFFFFFull
#endif
#ifndef DBL_MASK
#define DBL_MASK 0ull
#endif
#ifndef ATT_REP
#define ATT_REP 1
#endif
#define SREP(k) (((((unsigned long long)DBL_MASK >> (k)) & 1ull)) ? 2 : 1)
#define REP(k) _Pragma("nounroll") for (int rep_ = 0; rep_ < ((((unsigned long long)DBL_MASK >> (k)) & 1ull) ? 2 : 1); ++rep_)

#define PH_ENV CArgs* ap = kargs(); unsigned char* ws = ap->ws; (void)ws; const int tid = TID(); (void)tid; const int G = ap->grid; (void)G;
#define XP      ((bf16_t*)(ws + WS_X))
#define HP      ((bf16_t*)(ws + WS_H))
#define RSP     ((float*)(ws + WS_RS))
#define RSGP    ((float*)(ws + WS_RSG))
#define ROWTOK  ((int*)(ws + WS_ROWTOK))
#define TOPE    ((int*)(ws + WS_TOPE))
#define TOPW    ((float*)(ws + WS_TOPW))
#define SLOTP   ((int*)(ws + WS_SLOT))
#define HDN     ((bf16_t*)(ws + WS_HDN))
#define YSB     ((bf16_t*)(ws + WS_YS))
#define CNTL(L) ((unsigned*)(ws + CTL_CNT) + (L) * 512)
#define ARP(off) (ws + WS_ARENA + (off))

#define TAIL_IDLE(n) ((((n) + G - 1) / G - 1) * G + bid >= (n))
#ifndef TQ_MOE1
#define TQ_MOE1 32
#define TQ_MOE2 8
#define TQ_WINQKV 32
#define TQ_S5IN 32
#define TQ_S5E 4
#define TQ_S5TF 8
#define TQ_S5GLU 16
#endif
#define MOE_BLOCK(L, p0, GNEXT_IDX, GNEXT_OFF, FINAL)                                                                                            \
    if (IN(p0)) { if ((CFG_MOE >> (L)) & 1) { PH_ENV if ((L) >= 1) catchup_convert(ap, lds, (L) * MOE_LAYER_TILES + MOE_GU_TILES, tid); router_phase(XP, RSGP, (const float*)(ws + WS_WRT) + (size_t)(L) * 36 * 2048, \
            TOPE, TOPW, SLOTP, ROWTOK, CNTL(L), lds, tid); } SEAM(p0); }                        \
    if (IN((p0) + 1)) { if ((CFG_MOE >> (L)) & 1) { PH_ENV moe_table(CNTL(L), lds, tid);                                                         \
            MoeSched<true> Sm; Sm.tle = (const LAS int*)(lds + LDS_TLE); Sm.tli = (const LAS int*)(lds + LDS_TLI); Sm.lc = (const LAS int*)(lds + LDS_CNT); Sm.rowtok = ROWTOK; \
            Sm.A = (const char*)XP; Sm.W = (const char*)(ws + WS_W_MOE + (size_t)(L) * 32 * MOE_LE_B); Sm.a_tile = 0; Sm.b_tile = (size_t)256 * 2048 * 2;  \
            Sm.ntiles = *(const LAS int*)(lds + LDS_NT); Sm.nN = 4; Sm.G = G; Sm.c = bid; Sm.rep = SREP((p0) + 1);                                                        \
            ep::MoeGU E{HDN, RSGP, (const LAS int*)(lds + LDS_CNT)}; pg::gemm_phase(lds, Sm, E, 2048, 2048, 2048, tid);                                                                        \
            if (Sm.my_units() < Sm.max_units()) tail_convert(ap, lds, TQ_MOE1, tid);                                                                    \
            catchup_convert(ap, lds, ((L) + 1) * MOE_LAYER_TILES, tid); } SEAM((p0) + 1); }                                                        \
    if (IN((p0) + 2)) { if ((CFG_MOE >> (L)) & 1) { PH_ENV if (MK_SPLIT) moe_table(CNTL(L), lds, tid);                                                         \
            MoeSched<false> Sm; Sm.tle = (const LAS int*)(lds + LDS_TLE); Sm.tli = (const LAS int*)(lds + LDS_TLI); Sm.lc = (const LAS int*)(lds + LDS_CNT); Sm.rowtok = ROWTOK; \
            Sm.A = (const char*)HDN; Sm.W = (const char*)(ws + WS_W_MOE + (size_t)(L) * 32 * MOE_LE_B + MOE_GU_B); Sm.a_tile = (size_t)256 * 512 * 2; Sm.b_tile = (size_t)256 * 512 * 2; \
            Sm.ntiles = *(const LAS int*)(lds + LDS_NT); Sm.nN = 8; Sm.G = G; Sm.c = bid; Sm.rep = SREP((p0) + 2);                                                        \
            ep::MoeDown E{YSB}; pg::gemm_phase(lds, Sm, E, 512, 512, 512, tid);                                                                          \
            if ((L) <= 2 && Sm.my_units() < Sm.max_units()) tail_convert(ap, lds, TQ_MOE2, tid); } SEAM((p0) + 2); }                                                    \
    if (IN((p0) + 3)) { PH_ENV if ((CFG_MOE >> (L)) & 1) norm_phase<1, FINAL, true>(XP, (FINAL) ? nullptr : XP, ap->in[GNEXT_IDX] + (GNEXT_OFF), HP, RSP, ap->out, YSB, TOPE, TOPW, SLOTP, CNTL(L), lds, tid); \
                        else norm_phase<0, FINAL, true>(XP, nullptr, ap->in[GNEXT_IDX] + (GNEXT_OFF), HP, RSP, ap->out, nullptr, nullptr, nullptr, nullptr, nullptr, lds, tid); SEAM((p0) + 3); }

__global__ void __launch_bounds__(NTHREADS, 2) mega(Args a_unused) {
    extern __shared__ __attribute__((aligned(16))) unsigned char lds_raw[];
    LAS unsigned char* lds = (LAS unsigned char*)lds_raw;
    const int wave_s = __builtin_amdgcn_readfirstlane(threadIdx.x >> 6);
    const int bid = __builtin_amdgcn_workgroup_id_x();
    int lo, hi, gsz; unsigned* barw;
    { PH_ENV lo = ap->ph_lo; hi = ap->ph_hi; gsz = G; barw = (unsigned*)(ws + CTL_BAR);
      if (tid < 4) ((LAS unsigned*)(lds + LDS_MISC))[tid] = 0u; }
    __syncthreads();
    XcdBarrier bar; bar.bar = barw; bar.x = 0; bar.st = (volatile LAS unsigned*)(lds + LDS_MISC); bar.G = (unsigned)gsz;
    if (hi - lo > 1) bar = xcd_barrier_post(barw, (volatile LAS unsigned*)(lds + LDS_MISC), TID(), (unsigned)gsz);
#define IN(k) ((((unsigned long long)PH_MASK >> (k)) & 1ull) && lo <= (k) && (k) < hi)
#define SEAM(k) do { if ((k) + 1 < hi) { xcd_barrier(bar, TID()); if (BAR_REP > 1) xcd_barrier(bar, TID()); } } while (0)

    if (IN(0)) REP(0) { PH_ENV
        if (bid < 64) s5_tables(ap, lds, bid, tid);
        prologue_weights(ap, lds, tid);
        norm_phase<0, false, false>(ap->in[I_X], ((CFG_MIX & 1) ? nullptr : XP), ap->in[I_LN_MIX], HP, RSP, nullptr, nullptr, nullptr, nullptr, nullptr, nullptr, lds, tid);
    }
    if (IN(0)) SEAM(0);
    {
#define GATE ((bf16_t*)ARP(AR_GATE))
#define XRP_ ((bf16_t*)ARP(AR_XRP))
#define XR_  ((bf16_t*)ARP(AR_XR))
#define YG_  ((bf16_t*)ARP(AR_YG))
#define LAB_ ((unsigned*)ARP(AR_LAB))
#define CHA_ ((float*)ARP(AR_CHA))
#define CHB_ ((float*)ARP(AR_CHB))
#define CAR_ ((float*)ARP(AR_CAR))
        constexpr bool ON = (CFG_MIX >> 0) & 1;
        if (IN(1)) { if (ON) { PH_ENV pg::DenseSched Sd; Sd.init(HP, ws + WS_W_LRU_IN, S_, 4096, 2048, 2048, G, bid); Sd.rep = SREP(1); ep::LruIn E{GATE, XRP_, RSP}; pg::gemm_phase(lds, Sd, E, 2048, 2048, 2048, tid); } SEAM(1); }
        if (IN(2)) { if (ON) REP(2) { PH_ENV lru_conv_phase(XRP_, ap->in[I_LRU_CONV_W], ap->in[I_LRU_CONV_B], XR_, tid); } SEAM(2); }
        if (IN(3)) { if (ON) { PH_ENV pg::GroupSched Sg; Sg.init(XR_, ws + WS_W_LRU_G, 8, S_, 1024, 2048, 256, (size_t)256 * 2, (size_t)1024 * 256 * 2, G, bid); Sg.rep = SREP(3);
                ep::LruGates E{XR_, ap->in[I_LRU_B_A], ap->in[I_LRU_B_X], (const float*)(ws + WS_SPT), LAB_}; pg::gemm_phase(lds, Sg, E, 256, 2048, 256, tid); } SEAM(3); }
        if (IN(4)) { if (ON) REP(4) { PH_ENV lru_scan1(LAB_, CHA_, CHB_, tid); } SEAM(4); }
        if (IN(6)) { if (ON) REP(6) { PH_ENV lru_scan3(LAB_, CHA_, CHB_, GATE, YG_, tid); } SEAM(6); }
        if (IN(7)) { if (ON) { PH_ENV pg::DenseSched Sd; Sd.init(YG_, ws + WS_W_LRU_O, S_, 2048, 2048, 2048, G, bid); Sd.rep = SREP(7); ep::Resid<true> E{ap->in[I_X], XP, 2048, nullptr}; pg::gemm_phase(lds, Sd, E, 2048, 2048, 2048, tid); } SEAM(7); }
    }
    MOE_BLOCK(0, 8, I_LN_MIX, 1 * 2048, false)
    {
#define AQ ((bf16_t*)ARP(AR_Q))
#define AK ((bf16_t*)ARP(AR_K))
#define AV ((bf16_t*)ARP(AR_V))
#define AO ((bf16_t*)ARP(AR_O))
#define AOD ((bf16_t*)ARP(AR_OD))
        constexpr bool ON = (CFG_MIX >> 1) & 1;
        if (IN(12)) { if (ON) { PH_ENV pg::DenseSched Sd; Sd.init(XP, ws + WS_W_DF_QKV, S_, 6144, 2048, 2048, G, bid); Sd.rep = SREP(12);
                ep::QkvRope E{AQ, AK, AV, 2048, 4096, (const float*)(ws + WS_ROPE), RSP}; pg::gemm_phase(lds, Sd, E, 2048, 2048, 2048, tid); } SEAM(12); }
        if (IN(13)) { if (ON) { PH_ENV
                const int lane_ = tid & 63; const float* lq1 = ap->in[I_DIFF_LQ1]; const float* lk1 = ap->in[I_DIFF_LK1]; const float* lq2 = ap->in[I_DIFF_LQ2]; const float* lk2 = ap->in[I_DIFF_LK2];
                const float s1_ = wave_sum(lq1[lane_] * lk1[lane_] + lq1[lane_ + 64] * lk1[lane_ + 64]), s2_ = wave_sum(lq2[lane_] * lk2[lane_] + lq2[lane_ + 64] * lk2[lane_ + 64]);
                constexpr float lam_init = 0.8f - 0.6f * 0.7408182206817179f; if (tid == 0) ((LAS float*)(lds + att::B2_LAM))[0] = expf(s1_) - expf(s2_) + lam_init; __syncthreads();
                for (int L0 = bid; L0 < 256 * ATT_REP; L0 += G) { const int L = L0 & 255; const int h = L & 7, qb = L >> 3;
                    float* scr = (float*)ARP(AR_O) + (size_t)bid * (512 * 128);
                    att::body2<128, 128, 128, 2048, 1>(AQ + ((size_t)(h * 2) * S_ + (size_t)qb * 256) * 128, AK + (size_t)(h * 2) * S_ * 128, AV + (size_t)(h * 2) * S_ * 128, AV + (size_t)(h * 2 + 1) * S_ * 128,
                                                       nullptr, 128, (LAS char*)lds, TID(), scr, 0.f, nullptr, 0.f);
                    att::body2<128, 128, 128, 2048, 2>(AQ + ((size_t)(h * 2 + 1) * S_ + (size_t)qb * 256) * 128, AK + (size_t)(h * 2 + 1) * S_ * 128, AV + (size_t)(h * 2) * S_ * 128, AV + (size_t)(h * 2 + 1) * S_ * 128,
                                                       AOD + (size_t)qb * 256 * 2048 + h * 256, 128, (LAS char*)lds, TID(), scr, 0.f, ap->in[I_DIFF_SUBLN], 1.0f - lam_init); } } SEAM(13); }
        if (IN(15)) { if (ON) { PH_ENV pg::DenseSched Sd; Sd.init(AOD, ws + WS_W_DF_O, S_, 2048, 2048, 2048, G, bid); Sd.rep = SREP(15); ep::Resid<false> E{XP, XP, 2048, nullptr}; pg::gemm_phase(lds, Sd, E, 2048, 2048, 2048, tid); } SEAM(15); }
    }
    MOE_BLOCK(1, 16, I_LN_MIX, 2 * 2048, false)
    {
        constexpr bool ON = (CFG_MIX >> 2) & 1;
        if (IN(20)) { if (ON) { PH_ENV pg::DenseSched Sd; Sd.init(XP, ws + WS_W_WN_QKV, S_, 3072, 2048, 2048, G, bid); Sd.rep = SREP(20);
                ep::QkvRope E{AQ, AK, AV, 2048, 2560, (const float*)(ws + WS_ROPE), RSP}; pg::gemm_phase(lds, Sd, E, 2048, 2048, 2048, tid);
                if (TAIL_IDLE(384)) tail_convert(ap, lds, TQ_WINQKV, tid); } SEAM(20); }
        if (IN(21)) { if (ON) { PH_ENV const float* sink = ap->in[I_WIN_SINK];
                for (int L = bid; L < 512; L += G) { const int head = (L >> 8) * 8 + (L & 7), qb = (L & 255) >> 3, kvh = head >> 2; const int q0 = qb * 256;
                    const int klo = q0 - 128 < 0 ? 0 : q0 - 128, khi = q0 + 384 > S_ ? S_ : q0 + 384;
                    att::body<128, 128, 128, 2048, true, 0>(AQ + ((size_t)head * S_ + q0) * 128, AK + ((size_t)kvh * S_ + klo) * 128, AV + ((size_t)kvh * S_ + klo) * 128,
                                                          AO + (size_t)q0 * 2048 + head * 128, (khi - klo) / 64, (LAS char*)lds, q0, klo, sink[head] * (1.0f / att::SCALE), tid); } } SEAM(21); }
        if (IN(22)) { if (ON) { PH_ENV pg::DenseSched Sd; Sd.init(AO, ws + WS_W_WN_O, S_, 2048, 2048, 2048, G, bid); Sd.rep = SREP(22); ep::Resid<false> E{XP, XP, 2048, nullptr}; pg::gemm_phase(lds, Sd, E, 2048, 2048, 2048, tid); } SEAM(22); }
    }
    MOE_BLOCK(2, 23, I_LN_MIX, 3 * 2048, false)
    {
#define SU  ((float*)ARP(AR_U))
#define SUA ((bf16_t*)ARP(AR_UA))
#define SSL ((float*)ARP(AR_SL))
#define SG  ((bf16_t*)ARP(AR_G))
#define SZ  ((bf16_t*)ARP(AR_Z))
        constexpr bool ON = (CFG_MIX >> 3) & 1;
        if (IN(27)) { if (ON) { PH_ENV pg::DenseSched Sd; Sd.init(XP, ws + WS_W_S5_IN, S_, 1024, 2048, 2048, G, bid); Sd.rep = SREP(27); ep::S5In E{SU, SUA, RSP}; pg::gemm_phase(lds, Sd, E, 2048, 2048, 2048, tid); if (TAIL_IDLE(128)) tail_convert(ap, lds, TQ_S5IN, tid); } SEAM(27); }
        if (IN(28)) { if (ON) { PH_ENV pg::GroupSched Sg; Sg.init(SUA, ws + WS_S5_E, 64, 512, 256, 512, 256, (size_t)512 * 512 * 2, (size_t)256 * 256 * 2, G, bid); Sg.rep = SREP(28);
                ep::F32Group E{SSL, 256, (size_t)512 * 256}; pg::gemm_phase(lds, Sg, E, 256, 512, 256, tid); if (TAIL_IDLE(128)) tail_convert(ap, lds, TQ_S5E, tid); } SEAM(28); }
        if (IN(29)) { if (ON) REP(29) { PH_ENV s5_carry(SSL, (const float*)(ws + WS_S5_LAM), SUA, lds, tid); } SEAM(29); }
        if (IN(30)) { if (ON) { PH_ENV pg::GroupSched Sg; Sg.init(SUA, ws + WS_S5_TF, 64, 512, 256, 512, 512, (size_t)512 * 512 * 2, (size_t)256 * 512 * 2, G, bid); Sg.rep = SREP(30);
                ep::S5Y E{SU, ap->in[I_S5_D], SG}; pg::gemm_phase(lds, Sg, E, 512, 512, 512, tid); if (TAIL_IDLE(128)) tail_convert(ap, lds, TQ_S5TF, tid); } SEAM(30); }
        if (IN(31)) { if (ON) { PH_ENV pg::DenseSched Sd; Sd.init(SG, ws + WS_W_S5_GLU, S_, 1024, 1024, 1024, G, bid); Sd.rep = SREP(31); ep::S5Glu E{SG, SZ}; pg::gemm_phase(lds, Sd, E, 1024, 1024, 1024, tid); if (TAIL_IDLE(128)) tail_convert(ap, lds, TQ_S5GLU, tid); } SEAM(31); }
        if (IN(32)) { if (ON) { PH_ENV pg::DenseSched Sd; Sd.init(SZ, ws + WS_W_S5_O, S_, 2048, 1024, 1024, G, bid); Sd.rep = SREP(32); ep::Resid<false> E{XP, XP, 2048, nullptr}; pg::gemm_phase(lds, Sd, E, 1024, 1024, 1024, tid); } SEAM(32); }
    }
    MOE_BLOCK(3, 33, I_LN_FINAL, 0, true)
#undef IN
#undef SEAM
}

extern "C" void kernel_launch(void* const* d_in, const int* in_sizes, int n_in, void* d_out, int out_size, void* d_ws, size_t ws_size, hipStream_t stream) {
    static int grid = 0;
    if (grid == 0) {
        if (n_in != N_INPUTS || out_size != S_ * D_ || ws_size < WS_END) { fprintf(stderr, "kernel_launch: unexpected shapes (n_in %d out %d ws %zu need %zu)\n", n_in, out_size, ws_size, (size_t)WS_END); grid = -1; return; }
        int dev = 0, cus = 0, per_cu = 0;
        if (hipGetDevice(&dev) != hipSuccess || hipDeviceGetAttribute(&cus, hipDeviceAttributeMultiprocessorCount, dev) != hipSuccess) { grid = -1; return; }
        if (hipFuncSetAttribute((const void*)mega, hipFuncAttributeMaxDynamicSharedMemorySize, LDS_BYTES) != hipSuccess) { fprintf(stderr, "kernel_launch: hipFuncSetAttribute failed\n"); grid = -1; return; }
        if (hipOccupancyMaxActiveBlocksPerMultiprocessor(&per_cu, (const void*)mega, NTHREADS, LDS_BYTES) != hipSuccess || per_cu < 1) { fprintf(stderr, "kernel_launch: occupancy query says %d\n", per_cu); }
        (void)hipGetLastError();
        grid = cus;
    }
    if (grid < 0) return;
    (void)hipMemsetAsync((char*)d_ws + WS_CTL, 0, CTL_BYTES, stream);
    Args a{};
    for (int i = 0; i < N_INPUTS; ++i) a.in[i] = (const float*)d_in[i];
    a.out = (float*)d_out; a.ws = (unsigned char*)d_ws;
    unsigned char* ws = (unsigned char*)d_ws;
    const DenseW dws[10] = {
        {a.in[I_LRU_W_IN],  (bf16_t*)(ws + WS_W_LRU_IN), 2048, 4096, a.in[I_LN_MIX]}, {a.in[I_LRU_W_OUT],  (bf16_t*)(ws + WS_W_LRU_O), 2048, 2048, nullptr},
        {a.in[I_DIFF_W_QKV], (bf16_t*)(ws + WS_W_DF_QKV), 2048, 6144, a.in[I_LN_MIX] + 2048}, {a.in[I_DIFF_W_OUT], (bf16_t*)(ws + WS_W_DF_O), 2048, 2048, nullptr},
        {a.in[I_WIN_W_QKV],  (bf16_t*)(ws + WS_W_WN_QKV), 2048, 3072, a.in[I_LN_MIX] + 2 * 2048}, {a.in[I_WIN_W_OUT],  (bf16_t*)(ws + WS_W_WN_O), 2048, 2048, nullptr},
        {a.in[I_S5_W_IN],    (bf16_t*)(ws + WS_W_S5_IN), 2048, 1024, a.in[I_LN_MIX] + 3 * 2048},  {a.in[I_S5_W_GLU],   (bf16_t*)(ws + WS_W_S5_GLU), 1024, 1024, nullptr},
        {a.in[I_S5_W_OUT],   (bf16_t*)(ws + WS_W_S5_O), 1024, 2048, nullptr},   {a.in[I_S5_W_OUT],   (bf16_t*)(ws + WS_W_S5_O), 1024, 0, nullptr} };
    for (int i = 0; i < 10; ++i) a.dw[i] = dws[i];
#if MK_SPLIT
    a.grid = grid;
    for (int p = 0; p < NPH; ++p) { a.ph_lo = p; a.ph_hi = p + 1; hipLaunchKernelGGL(mega, dim3(grid), dim3(NTHREADS), LDS_BYTES, stream, a); }
#else
    a.grid = grid; a.ph_lo = 0; a.ph_hi = NPH; hipLaunchKernelGGL(mega, dim3(grid), dim3(NTHREADS), LDS_BYTES, stream, a);
#endif
}
```
